# Optimizing an MI355X kernel written in HIP

```python
import jax
import jax.numpy as jnp
from jax import lax
import numpy as np

D_MODEL = 1024
BATCH = 16
SEQ = 4096
DEPTH = 1

HEAD_DIM = 64
ATTN_GROUPS = ((128, 1), (512, 4), (2048, 16))
HEADS_PER_GROUP = 4
N_ATTN_HEADS = HEADS_PER_GROUP * len(ATTN_GROUPS)
ATTN_WIDTH = N_ATTN_HEADS * HEAD_DIM
ATTN_OUT_WIDTH = HEADS_PER_GROUP * HEAD_DIM
LRU_WIDTH = D_MODEL
LRU_BLOCKS = 16
LRU_BLOCK_WIDTH = LRU_WIDTH // LRU_BLOCKS
LRU_C = 8.0
CONV_WIDTH = 4
N_EXPERTS = 16
CAPACITY_FACTOR = 2
EXPERT_FF = 2 * D_MODEL
ROPE_THETA = 10000.0
NORM_EPS = 1e-6
NEG_INF = -1e30
IN_WIDTH = 3 * ATTN_WIDTH + 2 * LRU_WIDTH + 2 * D_MODEL
IN_SPLITS = (ATTN_WIDTH, 2 * ATTN_WIDTH, 3 * ATTN_WIDTH, 3 * ATTN_WIDTH + LRU_WIDTH,
             3 * ATTN_WIDTH + 2 * LRU_WIDTH, 3 * ATTN_WIDTH + 2 * LRU_WIDTH + D_MODEL)

kernel_name = 'hybrid_dilated_attn_rglru_ec_moe_block'


def rms_norm(t, w):
    t32 = t.astype(jnp.float32)
    y = t32 * lax.rsqrt(jnp.mean(t32 * t32, axis=-1, keepdims=True) + NORM_EPS)
    return (y * w.astype(jnp.float32)).astype(t.dtype)


def modulate(t, shift, scale):
    return t * (1.0 + scale[:, None, :]) + shift[:, None, :]


def apply_rope(t, positions):
    half = HEAD_DIM // 2
    inv_freq = ROPE_THETA ** (-jnp.arange(half, dtype=jnp.float32) / half)
    ang = positions.astype(jnp.float32)[:, :, None, None] * inv_freq
    cos, sin = jnp.cos(ang), jnp.sin(ang)
    t32 = t.astype(jnp.float32)
    t1, t2 = t32[..., :half], t32[..., half:]
    return jnp.concatenate([t1 * cos - t2 * sin, t2 * cos + t1 * sin], axis=-1).astype(t.dtype)


def banded_attention(q, k, v, half):
    n, length, heads, dh = q.shape
    blk = half
    nb = -(-length // blk)
    extra = nb * blk - length
    q_b = jnp.pad(q, ((0, 0), (0, extra), (0, 0), (0, 0))).reshape(n, nb, blk, heads, dh)
    kv_pad = ((0, 0), (blk, blk + extra), (0, 0), (0, 0))
    k_b = jnp.pad(k, kv_pad).reshape(n, nb + 2, blk, heads, dh)
    v_b = jnp.pad(v, kv_pad).reshape(n, nb + 2, blk, heads, dh)

    def band(t):
        return jnp.concatenate([t[:, :-2], t[:, 1:-1], t[:, 2:]], axis=2)

    k_w, v_w = band(k_b), band(v_b)
    valid = jnp.pad(jnp.ones((length,), dtype=bool), (blk, blk + extra)).reshape(nb + 2, blk)
    valid_w = jnp.concatenate([valid[:-2], valid[1:-1], valid[2:]], axis=1)
    rel = jnp.arange(3 * blk)[None, :] - blk - jnp.arange(blk)[:, None]
    mask = (jnp.abs(rel) <= half)[None] & valid_w[:, None, :]
    s = jnp.einsum('nbqhd,nbkhd->nbhqk', q_b, k_w).astype(jnp.float32) * (dh ** -0.5)
    s = jnp.where(mask[None, :, None], s, NEG_INF)
    m = jnp.max(s, axis=-1, keepdims=True)
    p = jnp.exp(s - m)
    den = jnp.sum(p, axis=-1)
    o = jnp.einsum('nbhqk,nbkhd->nbqhd', p, v_w.astype(jnp.float32))
    o = o / jnp.swapaxes(den, 2, 3)[..., None]
    lse = jnp.swapaxes(m[..., 0] + jnp.log(den), 2, 3)
    o = o.reshape(n, nb * blk, heads, dh)[:, :length]
    lse = lse.reshape(n, nb * blk, heads)[:, :length]
    return o, lse


def dilated_window_attention(q, k, v, window, dilation):
    b, s, heads, dh = q.shape
    length = s // dilation

    def to_classes(t):
        return t.reshape(b, length, dilation, heads, dh).transpose(0, 2, 1, 3, 4).reshape(b * dilation, length, heads, dh)

    o, lse = banded_attention(to_classes(q), to_classes(k), to_classes(v), window // (2 * dilation))
    o = o.reshape(b, dilation, length, heads, dh).transpose(0, 2, 1, 3, 4).reshape(b, s, heads, dh)
    lse = lse.reshape(b, dilation, length, heads).transpose(0, 2, 1, 3).reshape(b, s, heads)
    return o, lse


def block_diag_linear(t, w):
    b, s, ch = t.shape
    y = jnp.einsum('bsnk,nkj->bsnj', t.reshape(b, s, LRU_BLOCKS, LRU_BLOCK_WIDTH), w.astype(t.dtype))
    return y.reshape(b, s, ch)


def rglru_coeffs(xc, w_a, b_a, w_x, b_x, lam):
    r = jax.nn.sigmoid(block_diag_linear(xc, w_a) + b_a.astype(jnp.float32))
    i = jax.nn.sigmoid(block_diag_linear(xc, w_x) + b_x.astype(jnp.float32))
    log_a = -LRU_C * r * jax.nn.softplus(-lam.astype(jnp.float32))
    a = jnp.exp(log_a)
    u = jnp.sqrt(-jnp.expm1(2.0 * log_a)) * (i * xc)
    return a, u


def linear_combine(e1, e2):
    a1, u1 = e1
    a2, u2 = e2
    return a1 * a2, a2 * u1 + u2


def mixer(h, positions, w_in, q_norm_w, k_norm_w, conv_w, conv_b, lru_w_a, lru_b_a, lru_w_x, lru_b_x,
          lru_lambda, w_attn_branch, w_lru_branch, w_out):
    b, s, _ = h.shape
    proj = h @ w_in
    q, k, v, xr, yr, g_attn, g_lru = jnp.split(proj, IN_SPLITS, axis=-1)

    q = apply_rope(rms_norm(q.reshape(b, s, N_ATTN_HEADS, HEAD_DIM), q_norm_w), positions)
    k = apply_rope(rms_norm(k.reshape(b, s, N_ATTN_HEADS, HEAD_DIM), k_norm_w), positions)
    v = v.reshape(b, s, N_ATTN_HEADS, HEAD_DIM)
    outs, lses = [], []
    for g, (window, dilation) in enumerate(ATTN_GROUPS):
        hs = slice(g * HEADS_PER_GROUP, (g + 1) * HEADS_PER_GROUP)
        o, lse = dilated_window_attention(q[:, :, hs], k[:, :, hs], v[:, :, hs], window, dilation)
        outs.append(o)
        lses.append(lse)
    grp_w = jax.nn.softmax(jnp.stack(lses), axis=0)
    attn = jnp.sum(grp_w[..., None] * jnp.stack(outs), axis=0).reshape(b, s, ATTN_OUT_WIDTH).astype(h.dtype)

    pad_l = CONV_WIDTH // 2
    pad_r = CONV_WIDTH - 1 - pad_l
    xc = lax.conv_general_dilated(xr, conv_w.astype(xr.dtype), window_strides=(1,), padding=[(pad_l, pad_r)],
                                  dimension_numbers=('NWC', 'WIO', 'NWC'), feature_group_count=LRU_WIDTH)
    xc = (xc + conv_b).astype(jnp.float32)
    a_f, u_f = rglru_coeffs(xc, lru_w_a[0], lru_b_a[0], lru_w_x[0], lru_b_x[0], lru_lambda[0])
    a_b, u_b = rglru_coeffs(xc, lru_w_a[1], lru_b_a[1], lru_w_x[1], lru_b_x[1], lru_lambda[1])
    _, h_fwd = lax.associative_scan(linear_combine, (a_f, u_f), axis=1)
    _, h_bwd = lax.associative_scan(linear_combine, (a_b, u_b), reverse=True, axis=1)
    lru = ((h_fwd + h_bwd) * jax.nn.gelu(yr.astype(jnp.float32))).astype(h.dtype)

    merged = jax.nn.sigmoid(g_attn) * (attn @ w_attn_branch) + jax.nn.sigmoid(g_lru) * (lru @ w_lru_branch)
    return merged @ w_out


def expert_choice_ffn(h, w_router, w_gate, w_up, w_down):
    b, s, _ = h.shape
    capacity = max(1, CAPACITY_FACTOR * s // N_EXPERTS)
    logits = jnp.einsum('bsd,de->bse', h, w_router).astype(jnp.float32)
    affinity = jax.nn.softmax(logits, axis=-1)
    gates, idx = lax.top_k(jnp.swapaxes(affinity, 1, 2), capacity)
    idx_e = jnp.swapaxes(idx, 0, 1)
    gates_e = jnp.swapaxes(gates, 0, 1).astype(h.dtype)
    bidx = jnp.arange(b)[:, None]

    def run_expert(args):
        ix, gt, wg, wu, wd = args
        xe = h[bidx, ix]
        he = jax.nn.silu(xe @ wg) * (xe @ wu)
        return (he @ wd) * gt[..., None]

    ys = lax.map(run_expert, (idx_e, gates_e, w_gate, w_up, w_down))
    return jnp.zeros_like(h).at[jnp.arange(b)[None, :, None], idx_e].add(ys)


def setup_inputs(seed: int = 0) -> dict:
    key = jax.random.key(seed)
    ks = jax.random.split(key, 26)

    def nrm(k, shape, scale):
        return jax.random.normal(k, shape, jnp.float32) * scale

    L = DEPTH
    a0 = jax.random.uniform(ks[14], (L, 2, LRU_WIDTH), jnp.float32, 0.9, 0.999)
    s0 = a0 ** (1.0 / LRU_C)
    lru_lambda = jnp.log(s0) - jnp.log1p(-s0)
    positions = (jnp.arange(SEQ, dtype=jnp.int32)[None, :]
                 + jax.random.randint(ks[2], (BATCH, 1), 0, 1024, dtype=jnp.int32))
    return {
        'x': nrm(ks[0], (BATCH, SEQ, D_MODEL), 1.0),
        'c': nrm(ks[1], (BATCH, D_MODEL), 1.0),
        'positions': positions,
        'w_ada': nrm(ks[3], (L, D_MODEL, 6 * D_MODEL), D_MODEL ** -0.5),
        'b_ada': nrm(ks[4], (L, 6 * D_MODEL), 0.01),
        'norm1_w': 1.0 + nrm(ks[5], (L, D_MODEL), 0.01),
        'w_in': nrm(ks[6], (L, D_MODEL, IN_WIDTH), D_MODEL ** -0.5),
        'q_norm_w': 1.0 + nrm(ks[7], (L, N_ATTN_HEADS, HEAD_DIM), 0.01),
        'k_norm_w': 1.0 + nrm(ks[8], (L, N_ATTN_HEADS, HEAD_DIM), 0.01),
        'conv_w': nrm(ks[9], (L, CONV_WIDTH, 1, LRU_WIDTH), CONV_WIDTH ** -0.5),
        'conv_b': nrm(ks[10], (L, LRU_WIDTH), 0.01),
        'lru_w_a': nrm(ks[11], (L, 2, LRU_BLOCKS, LRU_BLOCK_WIDTH, LRU_BLOCK_WIDTH), LRU_BLOCK_WIDTH ** -0.5),
        'lru_b_a': nrm(ks[12], (L, 2, LRU_WIDTH), 0.01),
        'lru_w_x': nrm(ks[13], (L, 2, LRU_BLOCKS, LRU_BLOCK_WIDTH, LRU_BLOCK_WIDTH), LRU_BLOCK_WIDTH ** -0.5),
        'lru_b_x': nrm(ks[15], (L, 2, LRU_WIDTH), 0.01),
        'lru_lambda': lru_lambda,
        'w_attn_branch': nrm(ks[16], (L, ATTN_OUT_WIDTH, D_MODEL), ATTN_OUT_WIDTH ** -0.5),
        'w_lru_branch': nrm(ks[17], (L, LRU_WIDTH, D_MODEL), LRU_WIDTH ** -0.5),
        'w_out': nrm(ks[18], (L, D_MODEL, D_MODEL), D_MODEL ** -0.5),
        'norm2_w': 1.0 + nrm(ks[19], (L, D_MODEL), 0.01),
        'w_router': nrm(ks[20], (L, D_MODEL, N_EXPERTS), D_MODEL ** -0.5),
        'w_gate': nrm(ks[21], (L, N_EXPERTS, D_MODEL, EXPERT_FF), D_MODEL ** -0.5),
        'w_up': nrm(ks[22], (L, N_EXPERTS, D_MODEL, EXPERT_FF), D_MODEL ** -0.5),
        'w_down': nrm(ks[23], (L, N_EXPERTS, EXPERT_FF, D_MODEL), EXPERT_FF ** -0.5),
    }


def reference(x, c, positions, w_ada, b_ada, norm1_w, w_in, q_norm_w, k_norm_w, conv_w, conv_b,
              lru_w_a, lru_b_a, lru_w_x, lru_b_x, lru_lambda, w_attn_branch, w_lru_branch, w_out,
              norm2_w, w_router, w_gate, w_up, w_down):
    c_act = jax.nn.silu(c)
    for l in range(DEPTH):
        mod = c_act @ w_ada[l] + b_ada[l]
        shift1, scale1, gate1, shift2, scale2, gate2 = jnp.split(mod, 6, axis=-1)
        h = modulate(rms_norm(x, norm1_w[l]), shift1, scale1)
        mix = mixer(h, positions, w_in[l], q_norm_w[l], k_norm_w[l], conv_w[l], conv_b[l], lru_w_a[l],
                    lru_b_a[l], lru_w_x[l], lru_b_x[l], lru_lambda[l], w_attn_branch[l], w_lru_branch[l], w_out[l])
        x = x + gate1[:, None, :] * mix
        h2 = modulate(rms_norm(x, norm2_w[l]), shift2, scale2)
        ffn = expert_choice_ffn(h2, w_router[l], w_gate[l], w_up[l], w_down[l])
        x = x + gate2[:, None, :] * ffn
    return x
```

```cpp
#include <hip/hip_runtime.h>
#include <cstdio>
#include <cstdint>

#ifndef MK_N_LAUNCHES
#define MK_N_LAUNCHES 1
#endif

#define LAS __attribute__((address_space(3)))
#define GAS __attribute__((address_space(1)))
typedef unsigned short bf16_t;
typedef short bf16x8 __attribute__((ext_vector_type(8)));
typedef short s16x4 __attribute__((ext_vector_type(4)));
typedef short v4i16_t __attribute__((ext_vector_type(4)));
typedef float f32x2 __attribute__((ext_vector_type(2)));
typedef float f32x4 __attribute__((ext_vector_type(4)));
typedef float f32x16 __attribute__((ext_vector_type(16)));
typedef unsigned u32x2 __attribute__((ext_vector_type(2)));
typedef _Float16 h16x2 __attribute__((ext_vector_type(2)));
typedef _Float16 h16x8 __attribute__((ext_vector_type(8)));
typedef unsigned u32x4 __attribute__((ext_vector_type(4)));

constexpr int NB = 16, SEQ = 4096, DM = 1024, NT = NB * SEQ;
constexpr int NIN = 6400, NE = 16, CAP = 512, FF = 2048;
constexpr int NWAVES = 8, NTHR = 512;
constexpr float NORM_EPS = 1e-6f;
constexpr float LOG2E = 1.4426950408889634f, LN2 = 0.6931471805599453f;

constexpr size_t MiB = 1u << 20;
constexpr size_t WS_CTL = 0, CTL_ZERO_BYTES = 64 * 1024;
constexpr size_t WS_MOD = 1 * MiB;
constexpr size_t WS_ROPE = 2 * MiB;
constexpr size_t WS_WIN = 18 * MiB;
constexpr size_t WS_WAB = WS_WIN + (size_t)NIN * DM * 2;
constexpr size_t WS_WLB = WS_WAB + (size_t)DM * 256 * 2;
constexpr size_t WS_WOUT = WS_WLB + (size_t)DM * DM * 2;
constexpr size_t WS_WLRU = WS_WOUT + (size_t)DM * DM * 2;
constexpr size_t WS_AFF = 36 * MiB;
constexpr size_t WS_GTS = 40 * MiB;
constexpr size_t WS_IDX = 40 * MiB + 512 * 1024;
constexpr size_t WS_SLOT = 41 * MiB;
constexpr size_t WS_LSE = 44 * MiB;
constexpr size_t WS_ATTN = 48 * MiB;
constexpr size_t WS_P = 80 * MiB;
constexpr size_t WS_QG = WS_P, WS_KG = WS_QG + 96 * MiB, WS_VG = WS_KG + 96 * MiB;
constexpr size_t WS_XR = WS_VG + 96 * MiB, WS_GY = WS_XR + 128 * MiB, WS_SGA = WS_GY + 128 * MiB, WS_SGL = WS_SGA + 128 * MiB;
constexpr size_t WS_PEND = WS_SGL + 128 * MiB;
constexpr size_t WS_LRU = WS_QG;
constexpr size_t WS_T1 = WS_LRU + 128 * MiB;
constexpr size_t WS_MRG = WS_XR;
constexpr size_t WS_HE = 48 * MiB;
constexpr size_t WS_WD = 880 * MiB;
constexpr size_t WS_WGU = WS_WD + 32 * MiB;
constexpr size_t WS_XE = WS_HE + 352 * MiB;
constexpr size_t WS_H2 = WS_XE + 128 * MiB;
constexpr size_t WS_YS = WS_H2 + 64 * MiB;
constexpr size_t WS_END = WS_YS + 256 * MiB;
constexpr int WGU_SCALE_LOG2 = 5, WD_SCALE_LOG2 = 6, WIN_SCALE_LOG2 = 5;
constexpr size_t WS_WIN8 = WS_LSE;
constexpr size_t DO_H18 = 128 * MiB;
static_assert(WS_PEND <= 1024 * MiB && WS_END <= 1024 * MiB, "d_ws map");
constexpr size_t DO_H1 = 0, DO_HF = 0, DO_OG = 128 * MiB;

constexpr int RING_BYTES = 131072;
constexpr int MISC_OFF = 163840 - 256;
constexpr int LDS_BYTES = 163840;

typedef __bf16 bf16x2v __attribute__((ext_vector_type(2)));
__device__ __forceinline__ unsigned cvt_pk_bf16(float lo, float hi) { const bf16x2v v = __builtin_convertvector((f32x2){lo, hi}, bf16x2v); return __builtin_bit_cast(unsigned, v); }
__device__ __forceinline__ float bf2f(unsigned short b) { return __uint_as_float(((unsigned)b) << 16); }
__device__ __forceinline__ float bflo(unsigned w) { return __uint_as_float(w << 16); }
__device__ __forceinline__ float bfhi(unsigned w) { return __uint_as_float(w & 0xffff0000u); }
__device__ __forceinline__ float fast_exp2(float x) { return __builtin_amdgcn_exp2f(x); }
__device__ __forceinline__ float fast_rcp(float x) { return __builtin_amdgcn_rcpf(x); }
__device__ __forceinline__ float sigmoidf_(float x) { return fast_rcp(1.0f + fast_exp2(-x * LOG2E)); }
__device__ __forceinline__ float gelu_tanh(float x) { const float u = 0.7978845608028654f * (x + 0.044715f * x * x * x); return x * fast_rcp(1.0f + fast_exp2(-2.0f * LOG2E * u)); }
__device__ __forceinline__ float wave_sum(float v) {
#pragma unroll
    for (int o = 1; o < 64; o <<= 1) v += __shfl_xor(v, o);
    return v;
}
__device__ __forceinline__ unsigned pk4_fp8(float a, float b, float c, float d) { unsigned w = 0u; w = __builtin_amdgcn_cvt_pk_fp8_f32(a, b, w, false); w = __builtin_amdgcn_cvt_pk_fp8_f32(c, d, w, true); return w; }
__device__ __forceinline__ unsigned pkh(float a, float b) { return __builtin_bit_cast(unsigned, __builtin_amdgcn_cvt_pkrtz(a, b)); }
__device__ __forceinline__ u32x4 pack8h(const f32x4 a, const f32x4 b) { u32x4 w; w.x = pkh(a[0], a[1]); w.y = pkh(a[2], a[3]); w.z = pkh(b[0], b[1]); w.w = pkh(b[2], b[3]); return w; }
__device__ __forceinline__ h16x2 ash2(unsigned w) { return __builtin_bit_cast(h16x2, w); }
__device__ __forceinline__ unsigned asu(h16x2 v) { return __builtin_bit_cast(unsigned, v); }
#define LDS_WAIT() asm volatile("s_waitcnt lgkmcnt(0)" ::: "memory")
#define VM_WAIT() asm volatile("s_waitcnt vmcnt(0)" ::: "memory")

namespace pg8 {
constexpr int BM = 256, BK = 64, HALF = 128, HTB = HALF * BK * 2, STAGE_BYTES = 8 * HTB, NXCD = 8, WGM = 8;
__host__ __device__ __forceinline__ int lds_byte(int r, int c) { const int st = (r >> 4) * 2 + (c >> 5), rr = r & 15, cc = c & 31, ob = rr * 64 + cc * 2; return st * 1024 + (ob ^ (((ob >> 9) & 1) << 5)); }
__host__ __device__ __forceinline__ void stage_rc(int b, int& R, int& C) { const int st = b / 1024, sb = b % 1024, swz = sb ^ (((sb >> 9) & 1) << 5); R = (st >> 1) * 16 + swz / 64; C = (st & 1) * 32 + (swz % 64) / 2; }
__host__ __device__ __forceinline__ int perm32(int rho) { const int n = rho >> 4, i = rho & 15; return 8 * (i >> 2) + 4 * n + (i & 3); }

struct Unit { int pm, pn; };
struct Gemm { const bf16_t* A; const bf16_t* Bt; int K; int mgrp; int nN; int wscale; const bf16_t* A2; const bf16_t* Bt2; int K2; };
typedef int v4i_t __attribute__((ext_vector_type(4)));
typedef int v8i_t __attribute__((ext_vector_type(8)));

struct StaticOrder {
    int nM, nN, nwg, G, c;
    __host__ __device__ __forceinline__ void init(int M, int N, int G_, int c_) { nM = M / BM; nN = N / BM; nwg = nM * nN; G = G_; c = c_; }
    __host__ __device__ __forceinline__ bool next(int i, Unit& u) const {
        const long L = (long)i * G + c; if (L >= nwg) return false;
        int wgid = (int)L; { const int q = nwg / NXCD, r = nwg % NXCD, xcd = wgid % NXCD, off = wgid / NXCD; wgid = (xcd < r ? xcd * (q + 1) : r * (q + 1) + (xcd - r) * q) + off; }
        const int nig = WGM * nN, gid = wgid / nig, fm = gid * WGM, gsz = (nM - fm) < WGM ? (nM - fm) : WGM;
        u.pm = fm + ((wgid % nig) % gsz); u.pn = (wgid % nig) / gsz; return true;
    }
};

struct NoMid { static constexpr bool DUAL = false; __device__ __forceinline__ void operator()(f32x4 (&)[2][2][4][2], const Unit&, int, int, int, int) const {} };
struct NoGather { static constexpr bool ON = false; __device__ __forceinline__ unsigned offs(int, const Unit&, int, int) const { return 0u; } };
template <class Epi, bool ALIGN_EPI, bool SP2, bool F8 = false, class Mid = NoMid, class AG = NoGather>
__device__ __forceinline__ void gemm_phase(LAS unsigned char* lds, const Gemm g, const StaticOrder& S, const Epi& E, const Mid& M = Mid(), const AG& GA = AG()) {
    constexpr bool GATHER = AG::ON; static_assert(!(GATHER && Mid::DUAL), "gather + dual not combined");
    constexpr bool DUAL = Mid::DUAL;
    const int tid = threadIdx.x, wid = __builtin_amdgcn_readfirstlane(tid >> 6), lane = tid & 63, wr = wid >> 2, wc = wid & 3, fr = lane & 15, fq = lane >> 4;
    const int K0 = g.K, K1 = DUAL ? g.K2 : g.K;
    unsigned vA0[2], vB0[2], vA1[2], vB1[2];
    int Rl[2], Cl[2];
#pragma unroll
    for (int i = 0; i < 2; ++i) { int R, C; stage_rc(tid * 16 + i * 8192, R, C); Rl[i] = R; Cl[i] = C; const int Rb = Epi::PERM ? ((R & ~31) + perm32(R & 31)) : R;
        vA0[i] = (unsigned)(R * K0 + C) * 2u; vB0[i] = (unsigned)(Rb * K0 + C) * 2u; vA1[i] = (unsigned)(R * K1 + C) * 2u; vB1[i] = (unsigned)(Rb * K1 + C) * 2u; }
    const unsigned kstep = (unsigned)(BK * 2);
    const unsigned hstep0 = (unsigned)HALF * K0 * 2u, hstep1 = (unsigned)HALF * K1 * 2u;
    const __amdgpu_buffer_rsrc_t rA0 = __builtin_amdgcn_make_buffer_rsrc((void*)g.A, 0, 0x7fffffff, 0x00020000), rB0 = __builtin_amdgcn_make_buffer_rsrc((void*)g.Bt, 0, 0x7fffffff, 0x00020000);
    const __amdgpu_buffer_rsrc_t rA1 = __builtin_amdgcn_make_buffer_rsrc((void*)(DUAL ? g.A2 : g.A), 0, 0x7fffffff, 0x00020000), rB1 = __builtin_amdgcn_make_buffer_rsrc((void*)(DUAL ? g.Bt2 : g.Bt), 0, 0x7fffffff, 0x00020000);
    __amdgpu_buffer_rsrc_t crA = rA0, crB = rB0;
    const unsigned ldsw = (unsigned)wid * 1024u;
    const int aoff = lds_byte(wr * 64 + fr, fq * 8), boff = lds_byte(wc * 32 + fr, fq * 8);
#define PG8_SA(b, h) (((b) * 2 + (h)) * HTB)
#define PG8_SB(b, h) ((4 + (b) * 2 + (h)) * HTB)
#define PG8_STAGE_R(bufoff, rs, soff, voff) do { _Pragma("unroll") for (int _i = 0; _i < 2; ++_i) \
        __builtin_amdgcn_raw_ptr_buffer_load_lds(rs, (LAS void*)(lds + (bufoff) + ldsw + _i * 8192), 16, (int)(voff)[_i], (int)(soff), 0, 0); } while (0)
#define PG8_STAGE_A(bufoff, soff, voff) PG8_STAGE_R(bufoff, crA, soff, voff)
#define PG8_STAGE_B(bufoff, soff, voff) PG8_STAGE_R(bufoff, crB, soff, voff)
#define PG8_LDA(dst, b, h) do { if constexpr (F8) { _Pragma("unroll") for (int m = 0; m < 4; ++m) { const v4i_t lo_ = *(const LAS v4i_t*)(lds + PG8_SA(b, h) + aoff + m * 2048), hi_ = *(const LAS v4i_t*)(lds + PG8_SA(b, h) + aoff + m * 2048 + 1024); \
            dst##8[m] = __builtin_shufflevector(lo_, hi_, 0, 1, 2, 3, 4, 5, 6, 7); } } \
        else { _Pragma("unroll") for (int m = 0; m < 4; ++m) _Pragma("unroll") for (int k = 0; k < 2; ++k) dst[m][k] = *(const LAS bf16x8*)(lds + PG8_SA(b, h) + aoff + m * 2048 + k * 1024); } } while (0)
#define PG8_LDB(dst, b, h) do { if constexpr (F8) { _Pragma("unroll") for (int n = 0; n < 2; ++n) { const v4i_t lo_ = *(const LAS v4i_t*)(lds + PG8_SB(b, h) + boff + n * 2048), hi_ = *(const LAS v4i_t*)(lds + PG8_SB(b, h) + boff + n * 2048 + 1024); \
            dst##8[n] = __builtin_shufflevector(lo_, hi_, 0, 1, 2, 3, 4, 5, 6, 7); } } \
        else { _Pragma("unroll") for (int n = 0; n < 2; ++n) _Pragma("unroll") for (int k = 0; k < 2; ++k) dst[n][k] = *(const LAS bf16x8*)(lds + PG8_SB(b, h) + boff + n * 2048 + k * 1024); } } while (0)
#define PG8_MMA(ai, bj, At, Bt) do { __builtin_amdgcn_s_setprio(1); \
        if constexpr (F8) { _Pragma("unroll") for (int m = 0; m < 4; ++m) _Pragma("unroll") for (int n = 0; n < 2; ++n) \
            asm volatile("v_mfma_scale_f32_16x16x128_f8f6f4 %0, %1, %2, %0, %3, %4 op_sel_hi:[0,0,0]" : "+v"(acc[ai][bj][m][n]) : "v"(Bt##8[n]), "v"(At##8[m]), "v"(wsc_), "v"(one_)); \
        } else { _Pragma("unroll") for (int m = 0; m < 4; ++m) _Pragma("unroll") for (int n = 0; n < 2; ++n) _Pragma("unroll") for (int k = 0; k < 2; ++k) \
            acc[ai][bj][m][n] = __builtin_amdgcn_mfma_f32_16x16x32_bf16(Bt[n][k], At[m][k], acc[ai][bj][m][n], 0, 0, 0); } \
        __builtin_amdgcn_s_setprio(0); } while (0)
#define PG8_WAIT_V(n) asm volatile("s_waitcnt vmcnt(" #n ")" ::: "memory")
#define PG8_WAIT_L(n) asm volatile("s_waitcnt lgkmcnt(" #n ")" ::: "memory")
#define PG8_BAR __builtin_amdgcn_s_barrier()
#define PG8_SCHED __builtin_amdgcn_sched_barrier(0)
#define PG8_BTILE(u) ((size_t)((g.mgrp ? ((u).pm / g.mgrp) * g.nN : 0) + (u).pn))
    Unit cur, nxt; int vi = 0, csub = 0, nsub = 0;
    if (!S.next(0, cur)) return;
    f32x4 acc[2][2][4][2];
#pragma unroll
    for (int a = 0; a < 2; ++a)
#pragma unroll
        for (int b = 0; b < 2; ++b)
#pragma unroll
            for (int m = 0; m < 4; ++m)
#pragma unroll
                for (int n = 0; n < 2; ++n) acc[a][b][m][n] = (f32x4){0.f, 0.f, 0.f, 0.f};
    bf16x8 At[4][2], B0[2][2], B1[2][2]; v8i_t At8[4], B08[2], B18[2];
    const int wsc_ = g.wscale, one_ = 0x7f7f7f7f;
    unsigned cA = (unsigned)cur.pm * 2u * hstep0, cB = (unsigned)PG8_BTILE(cur) * 2u * hstep0;
    unsigned chs = hstep0; unsigned cvA[2] = {vA0[0], vA0[1]}, cvB[2] = {vB0[0], vB0[1]}; int cnt = K0 / BK;
    unsigned cA0[2], cA1[2];
#pragma unroll
    for (int i = 0; i < 2; ++i) { if constexpr (GATHER) { cA0[i] = GA.offs(0, cur, Rl[i], Cl[i]); cA1[i] = GA.offs(0, cur, 128 + Rl[i], Cl[i]); } else { cA0[i] = cvA[i]; cA1[i] = cvA[i] + (unsigned)chs; } }
    if constexpr (GATHER) cA = 0u;
    if constexpr (SP2) {
        PG8_STAGE_B(PG8_SB(0, 0), cB, cvB); PG8_STAGE_B(PG8_SB(0, 1), cB + chs, cvB); PG8_STAGE_A(PG8_SA(0, 0), cA, cA0); PG8_STAGE_A(PG8_SA(0, 1), cA, cA1);
        if (wr == 1) PG8_BAR;
        PG8_WAIT_V(2); PG8_BAR;
        PG8_STAGE_B(PG8_SB(1, 0), cB + kstep, cvB); PG8_STAGE_A(PG8_SA(1, 0), cA + kstep, cA0); PG8_STAGE_B(PG8_SB(1, 1), cB + chs + kstep, cvB);
        PG8_WAIT_V(6); PG8_BAR;
    } else {
        PG8_STAGE_B(PG8_SB(0, 0), cB, cvB); PG8_STAGE_A(PG8_SA(0, 0), cA, cA0); PG8_STAGE_B(PG8_SB(0, 1), cB + chs, cvB); PG8_STAGE_A(PG8_SA(0, 1), cA, cA1);
        if (wr == 1) PG8_BAR;
        PG8_WAIT_V(4); PG8_BAR;
        PG8_STAGE_B(PG8_SB(1, 0), cB + kstep, cvB); PG8_STAGE_A(PG8_SA(1, 0), cA + kstep, cA0); PG8_STAGE_B(PG8_SB(1, 1), cB + chs + kstep, cvB);
        PG8_WAIT_V(6); PG8_BAR;
    }
    for (;;) {
        bool has_next;
        if (DUAL && csub == 0) { nxt = cur; nsub = 1; has_next = true; } else { nsub = 0; has_next = S.next((DUAL ? (vi >> 1) : vi) + 1, nxt); }
        const unsigned nhs = has_next ? (nsub ? hstep1 : hstep0) : chs;
        unsigned nvA[2], nvB[2];
#pragma unroll
        for (int i = 0; i < 2; ++i) { nvA[i] = has_next ? (nsub ? vA1[i] : vA0[i]) : cvA[i]; nvB[i] = has_next ? (nsub ? vB1[i] : vB0[i]) : cvB[i]; }
        unsigned nA0[2], nA1[2];
#pragma unroll
        for (int i = 0; i < 2; ++i) { if constexpr (GATHER) { nA0[i] = has_next ? GA.offs(vi + 1, nxt, Rl[i], Cl[i]) : cA0[i]; nA1[i] = has_next ? GA.offs(vi + 1, nxt, 128 + Rl[i], Cl[i]) : cA1[i]; } else { nA0[i] = nvA[i]; nA1[i] = nvA[i] + (unsigned)nhs; } }
        const unsigned nA = GATHER ? 0u : (has_next ? (unsigned)nxt.pm * 2u * nhs : cA), nB = has_next ? (unsigned)PG8_BTILE(nxt) * 2u * nhs : cB;
#pragma nounroll
        for (int t = 0; t < cnt; t += 2) {
            const bool last = (t == cnt - 2);
            const unsigned a1 = cA + (unsigned)(t + 1) * kstep;
            const unsigned a2 = last ? nA : cA + (unsigned)(t + 2) * kstep, b2 = last ? nB : cB + (unsigned)(t + 2) * kstep;
            const unsigned a3 = a2 + kstep, b3 = b2 + kstep;
            const unsigned hs2 = (DUAL && last) ? nhs : chs;
            unsigned wA[2], wB[2];
#pragma unroll
            for (int i = 0; i < 2; ++i) { wA[i] = ((DUAL || GATHER) && last) ? nA0[i] : cA0[i]; wB[i] = (DUAL && last) ? nvB[i] : cvB[i]; }
            unsigned wA1[2];
#pragma unroll
            for (int i = 0; i < 2; ++i) wA1[i] = ((DUAL || GATHER) && last) ? nA1[i] : cA1[i];
            __amdgpu_buffer_rsrc_t wrA = crA, wrB = crB;
            if (DUAL && last && has_next) { wrA = nsub ? rA1 : rA0; wrB = nsub ? rB1 : rB0; }
            if constexpr (SP2) {
            PG8_LDB(B0, 0, 0); PG8_LDB(B1, 0, 1); PG8_SCHED; PG8_LDA(At, 0, 0); PG8_STAGE_A(PG8_SA(1, 1), a1, cA1);
            PG8_WAIT_V(8); PG8_WAIT_L(0); PG8_BAR; PG8_MMA(0, 0, At, B0); PG8_MMA(0, 1, At, B1); PG8_BAR; PG8_SCHED;
            PG8_LDA(At, 0, 1); PG8_STAGE_R(PG8_SB(0, 0), wrB, b2, wB); PG8_STAGE_R(PG8_SB(0, 1), wrB, b2 + hs2, wB); PG8_STAGE_R(PG8_SA(0, 0), wrA, a2, wA);
            PG8_WAIT_V(8); PG8_WAIT_L(0); PG8_BAR; PG8_MMA(1, 0, At, B0); PG8_MMA(1, 1, At, B1); PG8_BAR; PG8_SCHED;
            PG8_LDB(B0, 1, 0); PG8_LDB(B1, 1, 1); PG8_SCHED; PG8_LDA(At, 1, 0); PG8_STAGE_R(PG8_SA(0, 1), wrA, a2, wA1);
            PG8_WAIT_V(8); PG8_WAIT_L(0); PG8_BAR; PG8_MMA(0, 0, At, B0); PG8_MMA(0, 1, At, B1); PG8_BAR; PG8_SCHED;
            PG8_LDA(At, 1, 1); PG8_STAGE_R(PG8_SB(1, 0), wrB, b3, wB); PG8_STAGE_R(PG8_SB(1, 1), wrB, b3 + hs2, wB); PG8_STAGE_R(PG8_SA(1, 0), wrA, a3, wA);
            PG8_WAIT_V(8); PG8_WAIT_L(0); PG8_BAR; PG8_MMA(1, 0, At, B0); PG8_MMA(1, 1, At, B1); PG8_BAR; PG8_SCHED;
            } else {
            PG8_LDB(B0, 0, 0); PG8_SCHED; PG8_LDA(At, 0, 0); PG8_STAGE_A(PG8_SA(1, 1), a1, cA1);
            PG8_WAIT_L(8); PG8_BAR; PG8_WAIT_L(0); PG8_MMA(0, 0, At, B0); PG8_BAR; PG8_SCHED;
            PG8_LDB(B1, 0, 1); PG8_STAGE_R(PG8_SB(0, 0), wrB, b2, wB);
            PG8_BAR; PG8_WAIT_L(0); PG8_MMA(0, 1, At, B1); PG8_BAR;
            PG8_LDA(At, 0, 1); PG8_STAGE_R(PG8_SA(0, 0), wrA, a2, wA);
            PG8_BAR; PG8_WAIT_L(0); PG8_MMA(1, 0, At, B0); PG8_BAR; PG8_SCHED;
            PG8_STAGE_R(PG8_SB(0, 1), wrB, b2 + hs2, wB);
            PG8_WAIT_V(6); PG8_BAR; PG8_MMA(1, 1, At, B1); PG8_BAR;
            PG8_LDB(B0, 1, 0); PG8_SCHED; PG8_LDA(At, 1, 0); PG8_STAGE_R(PG8_SA(0, 1), wrA, a2, wA1);
            PG8_WAIT_L(8); PG8_BAR; PG8_WAIT_L(0); PG8_MMA(0, 0, At, B0); PG8_BAR; PG8_SCHED;
            PG8_LDB(B1, 1, 1); PG8_STAGE_R(PG8_SB(1, 0), wrB, b3, wB);
            PG8_BAR; PG8_WAIT_L(0); PG8_MMA(0, 1, At, B1); PG8_BAR;
            PG8_LDA(At, 1, 1); PG8_STAGE_R(PG8_SA(1, 0), wrA, a3, wA);
            PG8_BAR; PG8_WAIT_L(0); PG8_MMA(1, 0, At, B0); PG8_BAR; PG8_SCHED;
            PG8_STAGE_R(PG8_SB(1, 1), wrB, b3 + hs2, wB);
            PG8_WAIT_V(6); PG8_BAR; PG8_MMA(1, 1, At, B1); PG8_BAR;
            }
        }
        if constexpr (ALIGN_EPI) { if (wr == 0) PG8_BAR; }
        if constexpr (F8) asm volatile("s_nop 15\n\ts_nop 7" ::: "memory");
        if (DUAL && csub == 0) M(acc, cur, wr, wc, fr, fq);
        else {
            E(acc, cur, wr, wc, fr, fq);
            if (!has_next) break;
#pragma unroll
            for (int a = 0; a < 2; ++a)
#pragma unroll
                for (int b = 0; b < 2; ++b)
#pragma unroll
                    for (int m = 0; m < 4; ++m)
#pragma unroll
                        for (int n = 0; n < 2; ++n) acc[a][b][m][n] = (f32x4){0.f, 0.f, 0.f, 0.f};
        }
        cur = nxt; csub = nsub; cA = nA; cB = nB; chs = nhs; cnt = (csub ? K1 : K0) / BK; ++vi;
        if constexpr (DUAL) { crA = csub ? rA1 : rA0; crB = csub ? rB1 : rB0; }
#pragma unroll
        for (int i = 0; i < 2; ++i) { cvA[i] = nvA[i]; cvB[i] = nvB[i]; cA0[i] = nA0[i]; cA1[i] = nA1[i]; }
        if constexpr (ALIGN_EPI) { if (wr == 1) PG8_BAR; }
    }
    PG8_WAIT_V(0);
    if constexpr (!ALIGN_EPI) { if (wr == 0) PG8_BAR; }
    PG8_BAR;
#undef PG8_SA
#undef PG8_SB
#undef PG8_STAGE_R
#undef PG8_STAGE_A
#undef PG8_STAGE_B
#undef PG8_LDA
#undef PG8_LDB
#undef PG8_MMA
#undef PG8_WAIT_V
#undef PG8_WAIT_L
#undef PG8_BAR
#undef PG8_SCHED
#undef PG8_BTILE
}
}
using pg8::Unit;

__device__ __forceinline__ int perm_row(int r, int sh) {
    const int b = r >> 12, t = r & 4095;
    return (b << 12) + ((t & ((1 << sh) - 1)) << (12 - sh)) + (t >> sh);
}
__device__ __forceinline__ u32x4 pack8(const f32x4 a, const f32x4 b) { u32x4 w; w.x = cvt_pk_bf16(a[0], a[1]); w.y = cvt_pk_bf16(a[2], a[3]); w.z = cvt_pk_bf16(b[0], b[1]); w.w = cvt_pk_bf16(b[2], b[3]); return w; }

struct EpiInProj {
    static constexpr bool PERM = true;
    bf16_t *QKV, *XR4; const float* cs; const float *qnw, *knw; int pn0;
    __device__ __forceinline__ void operator()(const f32x4 (&acc)[2][2][4][2], const Unit& u, int wr, int wc, int fr, int fq) const {
        const int pn = u.pn + pn0; const int row0 = u.pm * 256 + wr * 64 + fr;
        if (pn < 6) {
            const bool isq = pn < 3; const int g = isq ? pn : pn - 3; const int head = 4 * g + wc;
            const float* nw = (isq ? qnw : knw) + head * 64 + 8 * fq;
            const f32x4 wl0 = *(const f32x4*)(nw), wl1 = *(const f32x4*)(nw + 4), wh0 = *(const f32x4*)(nw + 32), wh1 = *(const f32x4*)(nw + 36);
            const float osc = isq ? 0.125f * LOG2E : 1.0f;
            bf16_t* dst = QKV + (size_t)pn * NT * 256;
            const int sh = 2 * g;
            f32x4 csv[2][2][4];
#define QK_LOAD(gi, buf) do { _Pragma("unroll") for (int mm = 0; mm < 2; ++mm) { const float* cr = cs + (size_t)(row0 + ((gi) >> 1) * 128 + (2 * ((gi) & 1) + mm) * 16) * 64 + 8 * fq; \
                csv[buf][mm][0] = *(const f32x4*)(cr); csv[buf][mm][1] = *(const f32x4*)(cr + 4); csv[buf][mm][2] = *(const f32x4*)(cr + 32); csv[buf][mm][3] = *(const f32x4*)(cr + 36); } } while (0)
            QK_LOAD(0, 0);
#pragma unroll
            for (int gi = 0; gi < 4; ++gi) {
                const int ai = gi >> 1, mb = 2 * (gi & 1), buf = gi & 1;
                u32x4 ol[2], oh[2];
#pragma unroll
                for (int mm = 0; mm < 2; ++mm) {
                    const int m = mb + mm;
                    const f32x4 v00 = acc[ai][0][m][0], v01 = acc[ai][0][m][1], v10 = acc[ai][1][m][0], v11 = acc[ai][1][m][1];
                    float ss = 0.f;
#pragma unroll
                    for (int j = 0; j < 4; ++j) ss += v00[j] * v00[j] + v01[j] * v01[j] + v10[j] * v10[j] + v11[j] * v11[j];
                    ss += __shfl_xor(ss, 16); ss += __shfl_xor(ss, 32);
                    const float rs = __builtin_amdgcn_rsqf(ss * (1.0f / 64.0f) + NORM_EPS);
                    const f32x4 c0 = csv[buf][mm][0], c1 = csv[buf][mm][1], s0 = csv[buf][mm][2], s1 = csv[buf][mm][3];
                    const f32x4 lo0 = v00 * rs * wl0, lo1 = v01 * rs * wl1, hi0 = v10 * rs * wh0, hi1 = v11 * rs * wh1;
                    const f32x4 L0 = (lo0 * c0 - hi0 * s0) * osc, L1 = (lo1 * c1 - hi1 * s1) * osc, H0 = (hi0 * c0 + lo0 * s0) * osc, H1 = (hi1 * c1 + lo1 * s1) * osc;
                    if (isq) { ol[mm] = pack8(L0, L1); oh[mm] = pack8(H0, H1); }
                    else { ol[mm].x = pk4_fp8(L0[0], L0[1], L0[2], L0[3]); ol[mm].y = pk4_fp8(L1[0], L1[1], L1[2], L1[3]); oh[mm].x = pk4_fp8(H0[0], H0[1], H0[2], H0[3]); oh[mm].y = pk4_fp8(H1[0], H1[1], H1[2], H1[3]); }
                }
                if (gi < 3) QK_LOAD(gi + 1, buf ^ 1);
#pragma unroll
                for (int mm = 0; mm < 2; ++mm) { const size_t rp = (size_t)perm_row(row0 + ai * 128 + (mb + mm) * 16, sh);
                    if (isq) { bf16_t* p = dst + rp * 256 + wc * 64 + 8 * fq; *(u32x4*)(p) = ol[mm]; *(u32x4*)(p + 32) = oh[mm]; }
                    else { unsigned char* p = (unsigned char*)(QKV + (size_t)3 * NT * 256) + (size_t)g * NT * 256 + rp * 256 + wc * 64 + 8 * fq;     *(u32x2*)(p) = (u32x2){ol[mm].x, ol[mm].y}; *(u32x2*)(p + 32) = (u32x2){oh[mm].x, oh[mm].y}; } }
            }
#undef QK_LOAD
        } else if (pn < 9) {
            const int g = pn - 6; bf16_t* dst = QKV + (size_t)pn * NT * 256; const int sh = 2 * g;
#pragma unroll
            for (int ai = 0; ai < 2; ++ai)
#pragma unroll
                for (int m = 0; m < 4; ++m) {
                    const int r = row0 + ai * 128 + m * 16; unsigned char* p = (unsigned char*)(QKV + (size_t)6 * NT * 256) + (size_t)g * NT * 256 + (size_t)perm_row(r, sh) * 256 + wc * 32 + 8 * fq;
#pragma unroll
                    for (int bj = 0; bj < 2; ++bj) { const f32x4 a = acc[ai][bj][m][0], b = acc[ai][bj][m][1]; *(u32x2*)(p + bj * 128) = (u32x2){pk4_fp8(a[0], a[1], a[2], a[3]), pk4_fp8(b[0], b[1], b[2], b[3])}; }
                }
        } else if (pn >= 17) {
            bf16_t* RT = XR4 + (size_t)2 * NT * 1024; bf16_t* SL = XR4 + (size_t)3 * NT * 1024; const int col0 = (pn - 17) * 128 + wc * 32 + 8 * fq;
#pragma unroll
            for (int ai = 0; ai < 2; ++ai)
#pragma unroll
                for (int m = 0; m < 4; ++m) {
                    const size_t off = (size_t)(row0 + ai * 128 + m * 16) * 1024 + col0;
                    f32x4 rt[2], sl[2];
#pragma unroll
                    for (int n = 0; n < 2; ++n)
#pragma unroll
                        for (int j = 0; j < 4; ++j) { const float ea = fast_exp2(-LOG2E * acc[ai][0][m][n][j]), el = fast_exp2(-LOG2E * acc[ai][1][m][n][j]);
                            sl[n][j] = fast_rcp(1.0f + el); rt[n][j] = (1.0f + el) * fast_rcp(1.0f + ea); }
                    *(u32x4*)(RT + off) = pack8(rt[0], rt[1]); *(u32x4*)(SL + off) = pack8(sl[0], sl[1]);
                }
        } else {
            const int kind = (pn - 9) >> 2, colbase = ((pn - 9) & 3) * 256;
            bf16_t* dst = XR4 + (size_t)kind * NT * 1024;
#pragma unroll
            for (int ai = 0; ai < 2; ++ai)
#pragma unroll
                for (int m = 0; m < 4; ++m) {
                    const int r = row0 + ai * 128 + m * 16; bf16_t* p = dst + (size_t)r * 1024 + colbase + wc * 32 + 8 * fq;
#pragma unroll
                    for (int bj = 0; bj < 2; ++bj) {
                        f32x4 a = acc[ai][bj][m][0], b = acc[ai][bj][m][1];
                        if (kind == 1) {
#pragma unroll
                            for (int j = 0; j < 4; ++j) { a[j] = gelu_tanh(a[j]); b[j] = gelu_tanh(b[j]); }
                        } else if (kind >= 2) {
#pragma unroll
                            for (int j = 0; j < 4; ++j) { a[j] = sigmoidf_(a[j]); b[j] = sigmoidf_(b[j]); }
                        }
                        *(u32x4*)(p + bj * 128) = pack8h(a, b);
                    }
                }
        }
    }
};
__device__ __forceinline__ void unpack8(const u32x4 w, f32x4& a, f32x4& b) { a = (f32x4){bflo(w.x), bfhi(w.x), bflo(w.y), bfhi(w.y)}; b = (f32x4){bflo(w.z), bfhi(w.z), bflo(w.w), bfhi(w.w)}; }
template <int MODE> struct EpiGate {
    static constexpr bool PERM = true;
    bf16_t* O; const bf16_t* G1; const bf16_t* ADD;
    __device__ __forceinline__ void operator()(const f32x4 (&acc)[2][2][4][2], const Unit& u, int wr, int wc, int fr, int fq) const {
        const int row0 = u.pm * 256 + wr * 64 + fr, col0 = u.pn * 256 + wc * 32 + 8 * fq;
        u32x4 g[2][2][2], t[2][2][2];
#define EG_LOAD(gi, buf) do { _Pragma("unroll") for (int mm = 0; mm < 2; ++mm) _Pragma("unroll") for (int bj = 0; bj < 2; ++bj) { \
            const size_t off = (size_t)(row0 + ((gi) >> 1) * 128 + (2 * ((gi) & 1) + mm) * 16) * 1024 + col0 + bj * 128; g[buf][mm][bj] = *(const u32x4*)(G1 + off); if (MODE == 1) t[buf][mm][bj] = *(const u32x4*)(ADD + off); } } while (0)
        EG_LOAD(0, 0);
#pragma unroll
        for (int gi = 0; gi < 4; ++gi) {
            const int ai = gi >> 1, mb = 2 * (gi & 1), buf = gi & 1;
            u32x4 o[2][2];
#pragma unroll
            for (int mm = 0; mm < 2; ++mm)
#pragma unroll
                for (int bj = 0; bj < 2; ++bj) {
                    f32x4 ga, gb; unpack8(g[buf][mm][bj], ga, gb);
                    f32x4 x = acc[ai][bj][mb + mm][0] * ga, y = acc[ai][bj][mb + mm][1] * gb;
                    if (MODE == 1) { f32x4 ta, tb; unpack8(t[buf][mm][bj], ta, tb); x += ta; y += tb; }
                    o[mm][bj] = pack8(x, y);
                }
            if (gi < 3) EG_LOAD(gi + 1, buf ^ 1);
#pragma unroll
            for (int mm = 0; mm < 2; ++mm)
#pragma unroll
                for (int bj = 0; bj < 2; ++bj) *(u32x4*)(O + (size_t)(row0 + ai * 128 + (mb + mm) * 16) * 1024 + col0 + bj * 128) = o[mm][bj];
        }
#undef EG_LOAD
    }
};
constexpr int GA_TAB_OFF = 131072;
struct GatherH2 {
    static constexpr bool ON = true;
    LAS unsigned short* tab;
    __device__ __forceinline__ unsigned offs(int ui, const Unit& u, int R, int C) const {
        const unsigned tok = tab[ui * 256 + R]; const unsigned b = ((unsigned)u.pm & 31u) >> 1;
        return ((b << 12) + tok) * 1024u + (unsigned)C * 2u;
    }
};
struct MidRatio {
    static constexpr bool DUAL = true;
    const bf16_t* RT;
    __device__ __forceinline__ void operator()(f32x4 (&acc)[2][2][4][2], const Unit& u, int wr, int wc, int fr, int fq) const {
        const int row0 = u.pm * 256 + wr * 64 + fr, col0 = u.pn * 256 + wc * 32 + 8 * fq;
        u32x4 ga[2][2][2];
#define MR_LOAD(gi, buf) do { _Pragma("unroll") for (int mm = 0; mm < 2; ++mm) _Pragma("unroll") for (int bj = 0; bj < 2; ++bj) \
            ga[buf][mm][bj] = *(const u32x4*)(RT + (size_t)(row0 + ((gi) >> 1) * 128 + (2 * ((gi) & 1) + mm) * 16) * 1024 + col0 + bj * 128); } while (0)
        MR_LOAD(0, 0);
#pragma unroll
        for (int gi = 0; gi < 4; ++gi) {
            const int ai = gi >> 1, mb = 2 * (gi & 1), buf = gi & 1;
            if (gi < 3) MR_LOAD(gi + 1, buf ^ 1);
#pragma unroll
            for (int mm = 0; mm < 2; ++mm)
#pragma unroll
                for (int bj = 0; bj < 2; ++bj) { f32x4 a0, a1; unpack8(ga[buf][mm][bj], a0, a1); acc[ai][bj][mb + mm][0] *= a0; acc[ai][bj][mb + mm][1] *= a1; }
        }
#undef MR_LOAD
    }
};
struct EpiX1 {
    static constexpr bool PERM = false;
    const float* x; float* out; const float* gate;
    __device__ __forceinline__ void operator()(const f32x4 (&acc)[2][2][4][2], const Unit& u, int wr, int wc, int fr, int fq) const {
        const int row0 = u.pm * 256 + wr * 64 + fr, col0 = u.pn * 256 + wc * 32 + 4 * fq;
        const float* gp = gate + (size_t)(u.pm >> 4) * 6144 + col0;
        f32x4 gv[2][2];
#pragma unroll
        for (int bj = 0; bj < 2; ++bj)
#pragma unroll
            for (int n = 0; n < 2; ++n) gv[bj][n] = *(const f32x4*)(gp + bj * 128 + n * 16);
        f32x4 xv[2][4][2][2];
#pragma unroll
        for (int m = 0; m < 4; ++m)
#pragma unroll
            for (int bj = 0; bj < 2; ++bj)
#pragma unroll
                for (int n = 0; n < 2; ++n) xv[0][m][bj][n] = *(const f32x4*)(x + (size_t)(row0 + m * 16) * 1024 + col0 + bj * 128 + n * 16);
#pragma unroll
        for (int ai = 0; ai < 2; ++ai) {
#pragma unroll
            for (int m = 0; m < 4; ++m)
#pragma unroll
                for (int bj = 0; bj < 2; ++bj)
#pragma unroll
                    for (int n = 0; n < 2; ++n) xv[ai][m][bj][n] += gv[bj][n] * acc[ai][bj][m][n];
            if (ai == 0) {
#pragma unroll
                for (int m = 0; m < 4; ++m)
#pragma unroll
                    for (int bj = 0; bj < 2; ++bj)
#pragma unroll
                        for (int n = 0; n < 2; ++n) xv[1][m][bj][n] = *(const f32x4*)(x + (size_t)(row0 + 128 + m * 16) * 1024 + col0 + bj * 128 + n * 16);
            }
#pragma unroll
            for (int m = 0; m < 4; ++m)
#pragma unroll
                for (int bj = 0; bj < 2; ++bj)
#pragma unroll
                    for (int n = 0; n < 2; ++n) *(f32x4*)(out + (size_t)(row0 + ai * 128 + m * 16) * 1024 + col0 + bj * 128 + n * 16) = xv[ai][m][bj][n];
        }
    }
};
struct EpiGU {
    static constexpr bool PERM = true;
    unsigned char* HE;
    __device__ __forceinline__ void operator()(const f32x4 (&acc)[2][2][4][2], const Unit& u, int wr, int wc, int fr, int fq) const {
        const int row0 = u.pm * 256 + wr * 64 + fr, col0 = u.pn * 128 + wc * 32 + 8 * fq;
#pragma unroll
        for (int ai = 0; ai < 2; ++ai)
#pragma unroll
            for (int m = 0; m < 4; ++m) {
                f32x4 o[2];
#pragma unroll
                for (int n = 0; n < 2; ++n)
#pragma unroll
                    for (int j = 0; j < 4; ++j) { const float gt = acc[ai][0][m][n][j];
                        o[n][j] = __builtin_amdgcn_fmed3f(gt * acc[ai][1][m][n][j] * fast_rcp(1.0f + fast_exp2(gt)), -448.f, 448.f); }
                u32x2 w; w.x = pk4_fp8(o[0][0], o[0][1], o[0][2], o[0][3]); w.y = pk4_fp8(o[1][0], o[1][1], o[1][2], o[1][3]);
                *(u32x2*)(HE + (size_t)(row0 + ai * 128 + m * 16) * FF + col0) = w;
            }
    }
};
constexpr float YS_SCALE = 16.0f;
struct EpiDown {
    static constexpr bool PERM = true;
    unsigned char* YS; const float* gts;
    __device__ __forceinline__ void operator()(const f32x4 (&acc)[2][2][4][2], const Unit& u, int wr, int wc, int fr, int fq) const {
        const int row0 = u.pm * 256 + wr * 64 + fr, col0 = u.pn * 256 + wc * 32 + 8 * fq;
        float gt[2][4];
#pragma unroll
        for (int ai = 0; ai < 2; ++ai)
#pragma unroll
            for (int m = 0; m < 4; ++m) gt[ai][m] = gts[row0 + ai * 128 + m * 16] * YS_SCALE;
#pragma unroll
        for (int ai = 0; ai < 2; ++ai)
#pragma unroll
            for (int m = 0; m < 4; ++m) {
                const int r = row0 + ai * 128 + m * 16;
#pragma unroll
                for (int bj = 0; bj < 2; ++bj) { const f32x4 a = acc[ai][bj][m][0] * gt[ai][m], b = acc[ai][bj][m][1] * gt[ai][m];
                    u32x2 w; w.x = pk4_fp8(a[0], a[1], a[2], a[3]); w.y = pk4_fp8(b[0], b[1], b[2], b[3]);
                    *(u32x2*)(YS + (size_t)r * 1024 + col0 + bj * 128) = w; }
            }
    }
};
#define XB_TMO      128
#define XB_XCNT(j)  (256  + 64 * (j))
#define XB_XSUB(j)  (1280 + 64 * (j))
#define XB_XGEN(j)  (2304 + 64 * (j))
#define XB_TOP      3328
#define XB_TOPGEN   3392
#define XCD_BAR_WORDS 3456
#define XB_SPIN_CAP (1u << 18)
__device__ __forceinline__ unsigned xb_ld(unsigned* p)              { return __hip_atomic_load(p, __ATOMIC_RELAXED, __HIP_MEMORY_SCOPE_AGENT); }
__device__ __forceinline__ unsigned xb_add(unsigned* p, unsigned v) { return __hip_atomic_fetch_add(p, v, __ATOMIC_RELAXED, __HIP_MEMORY_SCOPE_AGENT); }
__device__ __forceinline__ unsigned xb_xcc_id() { return (unsigned)__builtin_amdgcn_s_getreg((3 << 11) | 20) & 0xFu; }
#define XB_SPIN(cond, bar) do { unsigned _sp = 0; while (cond) { __builtin_amdgcn_s_sleep(1); \
    if ((++_sp & 255u) == 0u) { if (xb_ld(&(bar)[XB_TMO])) break; if (_sp > XB_SPIN_CAP) { atomicAdd(&(bar)[XB_TMO], 1u); break; } } } } while (0)
struct XcdBarrier { unsigned* bar; unsigned x; volatile LAS unsigned* st; };
__device__ __forceinline__ XcdBarrier xcd_barrier_post(unsigned* bar, volatile LAS unsigned* st) {
    XcdBarrier b; b.bar = bar; b.x = xb_xcc_id(); b.st = st;
    if (threadIdx.x == 0) (void)xb_add(&bar[XB_XCNT(b.x)], 1u);
    return b;
}
__device__ __forceinline__ void xcd_barrier_complete(unsigned* bar, unsigned x, unsigned& nloc, unsigned& nx) {
    const unsigned G = gridDim.x * gridDim.y * gridDim.z;
    unsigned sum, cnt, mine, sp = 0u;
    for (;;) {
        sum = 0u; cnt = 0u; mine = 0u;
#pragma unroll
        for (unsigned j = 0; j < 16; ++j) { const unsigned c = xb_ld(&bar[XB_XCNT(j)]); sum += c; cnt += (c > 0u) ? 1u : 0u; mine = (j == x) ? c : mine; }
        if (sum == G) break;
        __builtin_amdgcn_s_sleep(1);
        if ((++sp & 255u) == 0u) { if (xb_ld(&bar[XB_TMO])) break; if (sp > XB_SPIN_CAP) { atomicAdd(&bar[XB_TMO], 1u); break; } }
    }
    nloc = mine > 0u ? mine : 1u; nx = cnt > 0u ? cnt : 1u;
}
__device__ __forceinline__ void xcd_barrier(const XcdBarrier& b) {
    asm volatile("s_waitcnt vmcnt(0)" ::: "memory");
    __syncthreads();
    if (threadIdx.x == 0) {
        unsigned* bar = b.bar;
        __builtin_amdgcn_s_waitcnt(0);
        unsigned nloc = b.st[0], nx = b.st[1];
        if (nloc == 0u) { xcd_barrier_complete(bar, b.x, nloc, nx); b.st[0] = nloc; b.st[1] = nx; }
        const unsigned old = xb_add(&bar[XB_XSUB(b.x)], 1u);
        const unsigned gen = old / nloc;
        if (old + 1u == (gen + 1u) * nloc) {
            __builtin_amdgcn_fence(__ATOMIC_RELEASE, "agent");
            asm volatile("s_waitcnt vmcnt(0)" ::: "memory");
            const unsigned og = xb_add(&bar[XB_TOP], 1u);
            const unsigned tg = og / nx;
            if (og + 1u == (tg + 1u) * nx) xb_add(&bar[XB_TOPGEN], 1u);
            else XB_SPIN(xb_ld(&bar[XB_TOPGEN]) == tg, bar);
            __builtin_amdgcn_fence(__ATOMIC_ACQUIRE, "agent");
            xb_add(&bar[XB_XGEN(b.x)], 1u);
            asm volatile("s_waitcnt vmcnt(0)" ::: "memory");
        } else {
            XB_SPIN(xb_ld(&bar[XB_XGEN(b.x)]) == gen, bar);
            __builtin_amdgcn_fence(__ATOMIC_ACQUIRE, "agent");
            asm volatile("s_waitcnt vmcnt(0)" ::: "memory");
        }
    }
    __syncthreads();
}

struct Frame { LAS unsigned char* lds; int tid, lane, wave, vcu, G; };

template <class RowMap>
__device__ __forceinline__ void transpose_item(const float* W, int K, int N, bf16_t* WT, const RowMap& rm, LAS float* scr, int item, int lane, float scale = 1.0f, bool f16out = false) {
    const int nblk = N / 32, kb = item / nblk, nb = item % nblk, k0 = 64 * kb, n0 = 32 * nb;
    float tv_[32];
#pragma unroll
    for (int i = 0; i < 32; ++i) tv_[i] = W[(size_t)(k0 + 2 * i + (lane >> 5)) * N + n0 + (lane & 31)];
#pragma unroll
    for (int i = 0; i < 32; ++i) scr[(2 * i + (lane >> 5)) * 33 + (lane & 31)] = tv_[i];
    LDS_WAIT();
    const int c = lane & 7;
#pragma unroll
    for (int j = 0; j < 4; ++j) { const int n = (lane >> 3) + 8 * j; const LAS float* s = scr + (8 * c) * 33 + n;
        u32x4 o;
        if (f16out) { o.x = pkh(s[0 * 33] * scale, s[1 * 33] * scale); o.y = pkh(s[2 * 33] * scale, s[3 * 33] * scale); o.z = pkh(s[4 * 33] * scale, s[5 * 33] * scale); o.w = pkh(s[6 * 33] * scale, s[7 * 33] * scale); }
        else { o.x = cvt_pk_bf16(s[0 * 33] * scale, s[1 * 33] * scale); o.y = cvt_pk_bf16(s[2 * 33] * scale, s[3 * 33] * scale); o.z = cvt_pk_bf16(s[4 * 33] * scale, s[5 * 33] * scale); o.w = cvt_pk_bf16(s[6 * 33] * scale, s[7 * 33] * scale); }
        *(u32x4*)(WT + (size_t)rm(n0 + n) * K + k0 + 8 * c) = o; }
    LDS_WAIT();
}
__device__ __forceinline__ void f8_item_load(const float* W, int N, int nblk, int item, int lane, f32x4 (&v)[16]) {
    const int kb = item / nblk, nb = item % nblk, k0 = 64 * kb, n0 = 64 * nb, n4 = lane & 15, kr = lane >> 4;
#pragma unroll
    for (int i = 0; i < 16; ++i) v[i] = *(const f32x4*)(W + (size_t)(k0 + 4 * i + kr) * N + n0 + 4 * n4);
}
template <class RowMap>
__device__ __forceinline__ void f8_item_finish(const f32x4 (&v)[16], int K, int nblk, unsigned char* WT, const RowMap& rm, float scale, LAS float* scr, int item, int lane) {
    const int kb = item / nblk, nb = item % nblk, k0 = 64 * kb, n0 = 64 * nb, n4 = lane & 15, kr = lane >> 4;
#pragma unroll
    for (int i = 0; i < 16; ++i)
#pragma unroll
        for (int j = 0; j < 4; ++j) scr[(4 * n4 + j) * 65 + 4 * i + kr] = v[i][j] * scale;
    LDS_WAIT();
    const int c = lane & 3;
#pragma unroll
    for (int it = 0; it < 4; ++it) {
        const int n = 16 * it + (lane >> 2); const LAS float* s = scr + n * 65 + 16 * c;
        u32x4 o; o.x = pk4_fp8(s[0], s[1], s[2], s[3]); o.y = pk4_fp8(s[4], s[5], s[6], s[7]); o.z = pk4_fp8(s[8], s[9], s[10], s[11]); o.w = pk4_fp8(s[12], s[13], s[14], s[15]);
        *(u32x4*)(WT + (size_t)rm(n0 + n) * K + k0 + 16 * c) = o;
    }
    LDS_WAIT();
}
__device__ __forceinline__ void f8r_item_load(const float* W, int N, int nblk, int item, int lane, f32x4 (&v)[16]) {
    const int kb = item / nblk, nb = item % nblk, k0 = 128 * kb + 16 * (lane >> 3), n0 = 32 * nb + 4 * (lane & 7);
#pragma unroll
    for (int i = 0; i < 16; ++i) v[i] = *(const f32x4*)(W + (size_t)(k0 + i) * N + n0);
}
template <class RowMap>
__device__ __forceinline__ void f8r_item_store(const f32x4 (&v)[16], int K, int nblk, unsigned char* WT, const RowMap& rm, float scale, int item, int lane) {
    const int kb = item / nblk, nb = item % nblk, k0 = 128 * kb + 16 * (lane >> 3), n0 = 32 * nb + 4 * (lane & 7);
#pragma unroll
    for (int j = 0; j < 4; ++j) {
        u32x4 o; o.x = pk4_fp8(v[0][j] * scale, v[1][j] * scale, v[2][j] * scale, v[3][j] * scale); o.y = pk4_fp8(v[4][j] * scale, v[5][j] * scale, v[6][j] * scale, v[7][j] * scale);
        o.z = pk4_fp8(v[8][j] * scale, v[9][j] * scale, v[10][j] * scale, v[11][j] * scale); o.w = pk4_fp8(v[12][j] * scale, v[13][j] * scale, v[14][j] * scale, v[15][j] * scale);
        *(u32x4*)(WT + (size_t)rm(n0 + j) * K + k0) = o;
    }
}
struct RmId { __device__ __forceinline__ int operator()(int n) const { return n; } };
struct RmWin { __device__ __forceinline__ int operator()(int n) const {
    if (n >= 4352) { const int gl = n >= 5376, c = n - (gl ? 5376 : 4352); return 4352 + (c >> 7) * 256 + gl * 128 + (c & 127); }
    if (n >= 1536) return n; const int nl = n & 255; return (n & ~255) + 128 * ((nl >> 5) & 1) + 32 * (nl >> 6) + (nl & 31); } };
struct RmGU { int up; __device__ __forceinline__ int operator()(int n) const { return (n >> 7) * 256 + up * 128 + (n & 127); } };

struct Ptrs {
    const float *x, *c; const int* positions; const float *w_ada, *b_ada, *norm1_w, *w_in, *q_norm_w, *k_norm_w, *conv_w, *conv_b, *lru_w_a, *lru_b_a, *lru_w_x, *lru_b_x, *lru_lambda,
        *w_attn_branch, *w_lru_branch, *w_out, *norm2_w, *w_router, *w_gate, *w_up, *w_down;
    float* out; unsigned char* ws;
};

constexpr int EXPERT_ITEMS_EARLY = 7, EXPERT_ITEMS_ALL = 12;
__device__ __forceinline__ void convert_expert_items(const Frame& F, const Ptrs& P, int j0, int j1) {
    const int gw = F.vcu * NWAVES + F.wave, NGW = F.G * NWAVES;
    constexpr int PER_E = 1536, NIT = 16 * PER_E;
    const float sgu = (float)(1 << WGU_SCALE_LOG2), sd = (float)(1 << WD_SCALE_LOG2);
#define F8_SRC(it, W_, N_, nblk_, r_) const int e_##r_ = (it) / PER_E, q_##r_ = (it) % PER_E, kind_##r_ = q_##r_ >> 9, r_ = q_##r_ & 511; \
    const float* W_ = (kind_##r_ == 0 ? wg_ : kind_##r_ == 1 ? wu_ : wd_) + (size_t)e_##r_ * DM * FF; const int N_ = kind_##r_ == 2 ? DM : FF, nblk_ = N_ / 32
    const float *wg_ = P.w_gate, *wu_ = P.w_up, *wd_ = P.w_down;
    asm volatile("" : "+s"(wg_), "+s"(wu_), "+s"(wd_));
    f32x4 va[16], vb[16];
    int it = gw + j0 * NGW;
    if (j0 < j1 && it < NIT) { F8_SRC(it, W0, N0, nb0, r0); f8r_item_load(W0, N0, nb0, r0, F.lane, va); }
    for (int j = j0; j < j1 && it < NIT; ++j, it += NGW) {
        const int itn = it + NGW;
        if (j + 1 < j1 && itn < NIT) { F8_SRC(itn, W1, N1, nb1, r1); f8r_item_load(W1, N1, nb1, r1, F.lane, vb); }
        {
            const int e = it / PER_E, q = it % PER_E, kind = q >> 9, r = q & 511;
            if (kind == 0) f8r_item_store(va, DM, FF / 32, (unsigned char*)(P.ws + WS_WGU) + (size_t)e * 4096 * DM, RmGU{0}, sgu * -LOG2E, r, F.lane);
            else if (kind == 1) f8r_item_store(va, DM, FF / 32, (unsigned char*)(P.ws + WS_WGU) + (size_t)e * 4096 * DM, RmGU{1}, sgu * -LN2, r, F.lane);
            else f8r_item_store(va, FF, DM / 32, (unsigned char*)(P.ws + WS_WD) + (size_t)e * DM * FF, RmId{}, sd, r, F.lane);
        }
#pragma unroll
        for (int i = 0; i < 16; ++i) va[i] = vb[i];
    }
#undef F8_SRC
}

__device__ __forceinline__ void phase_prologue(const Frame& F, const Ptrs& P) {
    float* mod = (float*)(P.ws + WS_MOD);
    if (F.vcu < 96) {
        LAS float* cT = (LAS float*)F.lds;
        LAS float* red = (LAS float*)(F.lds + 65536);
        {   float cv_[32];
#pragma unroll
            for (int q = 0; q < 32; ++q) cv_[q] = P.c[F.tid + NTHR * q];
#pragma unroll
            for (int q = 0; q < 32; ++q) { const int i = F.tid + NTHR * q, b = i >> 10, k = i & 1023; cT[k * 16 + b] = cv_[q] * sigmoidf_(cv_[q]); } }
        __syncthreads();
        const int col0 = 64 * F.vcu;
        float acc[16];
#pragma unroll
        for (int b = 0; b < 16; ++b) acc[b] = 0.f;
        const float* wp = P.w_ada + (size_t)(F.wave * 128) * 6144 + col0 + F.lane;
        float wa[32], wb[32];
#pragma unroll
        for (int q = 0; q < 32; ++q) wa[q] = wp[(size_t)q * 6144];
#pragma unroll
        for (int bt = 0; bt < 4; ++bt) {
            if (bt < 3) {
#pragma unroll
                for (int q = 0; q < 32; ++q) wb[q] = wp[(size_t)(32 * (bt + 1) + q) * 6144];
            }
#pragma unroll
            for (int q = 0; q < 32; ++q) {
                const int k = F.wave * 128 + 32 * bt + q; const float wv = wa[q];
                const LAS f32x4* cp = (const LAS f32x4*)(cT + k * 16);
#pragma unroll
                for (int qq = 0; qq < 4; ++qq) { const f32x4 cv = cp[qq]; acc[4 * qq] += cv[0] * wv; acc[4 * qq + 1] += cv[1] * wv; acc[4 * qq + 2] += cv[2] * wv; acc[4 * qq + 3] += cv[3] * wv; }
            }
#pragma unroll
            for (int q = 0; q < 32; ++q) wa[q] = wb[q];
        }
#pragma unroll
        for (int b = 0; b < 16; ++b) red[(F.wave * 16 + b) * 64 + F.lane] = acc[b];
        __syncthreads();
        for (int o = F.tid; o < 1024; o += NTHR) { const int b = o >> 6, cl = o & 63; float s = P.b_ada[col0 + cl];
#pragma unroll
            for (int w = 0; w < 8; ++w) s += red[(w * 16 + b) * 64 + cl];
            mod[b * 6144 + col0 + cl] = s; }
        __syncthreads();
    }
    {
        float* cs = (float*)(P.ws + WS_ROPE);
        const int e0_ = F.vcu * NTHR + F.tid, estr_ = F.G * NTHR;
        for (int eb = e0_; eb < NT * 32; eb += 8 * estr_) {
          int pos_[8];
#pragma unroll
          for (int q = 0; q < 8; ++q) { const int e = eb + q * estr_; pos_[q] = e < NT * 32 ? P.positions[e >> 5] : 0; }
#pragma unroll
          for (int q = 0; q < 8; ++q) {
            const int e = eb + q * estr_; if (e >= NT * 32) break;
            const int r = e >> 5, d = e & 31;
            const float inv = exp2f(-(float)d * (13.287712379549449f / 32.0f));
            const float ang = (float)pos_[q] * inv;
            const double rev = (double)ang * 0.15915494309189535; const float fr = (float)(rev - rint(rev));
            cs[(size_t)r * 64 + d] = __builtin_amdgcn_cosf(fr); cs[(size_t)r * 64 + 32 + d] = __builtin_amdgcn_sinf(fr);
          }
        }
    }
    {
        LAS float* scr = (LAS float*)(F.lds + F.wave * 16640);
        const int gw = F.vcu * NWAVES + F.wave, NGW = F.G * NWAVES;
        constexpr int I_IN = 16 * 128, I_AB = 4 * 32, I_LB = 16 * 32, I_OUT = 16 * 32, I_LRU = 128, I_IN8 = 16 * 36;
        constexpr int NITEMS = I_IN + I_AB + I_LB + I_OUT + I_LRU + I_IN8;
        for (int it = gw; it < NITEMS; it += NGW) {
            int r = it;
            if (r >= NITEMS - I_IN8) {
                r -= NITEMS - I_IN8; const int kb = r / 36, nb = r % 36; f32x4 v16[16];
                f8_item_load(P.w_in, NIN, NIN / 64, kb * (NIN / 64) + nb, F.lane, v16);
                f8_item_finish(v16, DM, NIN / 64, (unsigned char*)(P.ws + WS_WIN8), RmWin{}, (float)(1 << WIN_SCALE_LOG2), (LAS float*)(F.lds + F.wave * 16640), kb * (NIN / 64) + nb, F.lane); continue; }
            if (r < I_IN) { transpose_item(P.w_in, DM, NIN, (bf16_t*)(P.ws + WS_WIN), RmWin{}, scr, (r >> 7) * 200 + 72 + (r & 127), F.lane); continue; } r -= I_IN;
            if (r < I_AB) { transpose_item(P.w_attn_branch, 256, DM, (bf16_t*)(P.ws + WS_WAB), RmId{}, scr, r, F.lane); continue; } r -= I_AB;
            if (r < I_LB) { transpose_item(P.w_lru_branch, DM, DM, (bf16_t*)(P.ws + WS_WLB), RmId{}, scr, r, F.lane); continue; } r -= I_LB;
            if (r < I_OUT) { transpose_item(P.w_out, DM, DM, (bf16_t*)(P.ws + WS_WOUT), RmId{}, scr, r, F.lane); continue; } r -= I_OUT;
            { const int blkid = r >> 1, sub = r & 1;
              const int gate = blkid >> 5, dir = (blkid >> 4) & 1, blk = blkid & 15;
              const float* src = (gate ? P.lru_w_x : P.lru_w_a) + (size_t)(dir * 16 + blk) * 4096;
              bf16_t* dst = (bf16_t*)(P.ws + WS_WLRU) + (size_t)(((dir * 16 + blk) * 2 + gate) * 64) * 64;
              transpose_item(src, 64, 64, dst, RmId{}, scr, sub, F.lane, -LOG2E, true); }
        }
    }
}

__device__ __forceinline__ void phase_h1(const Frame& F, const Ptrs& P) {
    const float* mod = (const float*)(P.ws + WS_MOD);
    bf16_t* h1 = (bf16_t*)((unsigned char*)P.out + DO_H1);
    const int gw = F.vcu * NWAVES + F.wave, NGW = F.G * NWAVES;
    const int rpw = (NT + NGW - 1) / NGW, r0 = gw * rpw, r1 = (r0 + rpw < NT) ? r0 + rpw : NT;
    f32x4 nw[4];
#pragma unroll
    for (int j = 0; j < 4; ++j) nw[j] = *(const f32x4*)(P.norm1_w + 256 * j + 4 * F.lane);
    f32x4 v[4], vn[4], sh[4], sc[4];
    int bcur = -1;
    if (r0 < r1) {
#pragma unroll
        for (int j = 0; j < 4; ++j) v[j] = ((const f32x4*)(P.x + (size_t)r0 * DM) + F.lane)[64 * j];
    }
    for (int r = r0; r < r1; ++r) {
        const int b = r >> 12, rn = r + 1;
        if (rn < r1) {
#pragma unroll
            for (int j = 0; j < 4; ++j) vn[j] = ((const f32x4*)(P.x + (size_t)rn * DM) + F.lane)[64 * j];
        }
        if (b != bcur) { bcur = b;
#pragma unroll
            for (int j = 0; j < 4; ++j) { const int k = 256 * j + 4 * F.lane; sh[j] = *(const f32x4*)(mod + b * 6144 + k); sc[j] = *(const f32x4*)(mod + b * 6144 + 1024 + k) + 1.0f; } }
        float s = 0.f;
#pragma unroll
        for (int j = 0; j < 4; ++j) s += v[j][0] * v[j][0] + v[j][1] * v[j][1] + v[j][2] * v[j][2] + v[j][3] * v[j][3];
        const float rs = __builtin_amdgcn_rsqf(wave_sum(s) * (1.0f / DM) + NORM_EPS);
        u32x2* o = (u32x2*)(h1 + (size_t)r * DM) + F.lane;
#pragma unroll
        for (int j = 0; j < 4; ++j) {
            const f32x4 y = v[j] * rs * nw[j] * sc[j] + sh[j];
            u32x2 pk; pk.x = cvt_pk_bf16(y[0], y[1]); pk.y = cvt_pk_bf16(y[2], y[3]); o[64 * j] = pk;
            ((unsigned*)((unsigned char*)P.out + DO_H18 + (size_t)r * DM) + F.lane)[64 * j] = pk4_fp8(y[0], y[1], y[2], y[3]);
        }
#pragma unroll
        for (int j = 0; j < 4; ++j) v[j] = vn[j];
    }
}

constexpr int VPITCH = 144;
__device__ __forceinline__ s16x4 vtr(const LAS unsigned char* p) { return __builtin_bit_cast(s16x4, __builtin_amdgcn_ds_read_tr16_b64_v4i16((LAS v4i16_t*)p)); }
__device__ __forceinline__ void expand_fp8x16(const u32x4 in, u32x4& o0, u32x4& o1) {
    const unsigned w[4] = {in.x, in.y, in.z, in.w}; unsigned o[8];
#pragma unroll
    for (int i = 0; i < 4; ++i) { const f32x2 lo = __builtin_amdgcn_cvt_pk_f32_fp8((int)w[i], false), hi = __builtin_amdgcn_cvt_pk_f32_fp8((int)w[i], true); o[2 * i] = cvt_pk_bf16(lo[0], lo[1]); o[2 * i + 1] = cvt_pk_bf16(hi[0], hi[1]); }
    o0 = (u32x4){o[0], o[1], o[2], o[3]}; o1 = (u32x4){o[4], o[5], o[6], o[7]};
}
constexpr int AT_K = 0, AT_V = 384 * VPITCH, AT_O = 2 * 384 * VPITCH;
constexpr int ATTN_NITEM = 3 * 4 * 256;
__device__ __forceinline__ void phase_attn(const Frame& F, const Ptrs& P, const int k0, const int k1) {
    const bf16_t* QG = (const bf16_t*)(P.ws + WS_QG); const bf16_t* KG = (const bf16_t*)(P.ws + WS_KG); const bf16_t* VG = (const bf16_t*)(P.ws + WS_VG);
    bf16_t* OG = (bf16_t*)((unsigned char*)P.out + DO_OG); float* LSE = (float*)(P.ws + WS_LSE);
    LAS unsigned char* kl = F.lds + AT_K; LAS unsigned char* vl = F.lds + AT_V;
    const int lane = F.lane, r31 = lane & 31, h = lane >> 5, w = F.wave;
    const int i16 = lane & 15, tq = i16 >> 2, tp = i16 & 3, dblk = (lane >> 4) & 1;
    const int prow = F.tid >> 2, pc4 = F.tid & 3;
    const unsigned char* K8 = (const unsigned char*)KG; const unsigned char* V8 = (const unsigned char*)VG;
    constexpr int NITEM = 3 * 4 * 256;
#define AT_DECODE(IT, g_, j_, Lg_, row0_, s0_, m0_, off_) const int g_ = (IT) >> 10, j_ = ((IT) >> 8) & 3, Lg_ = SEQ >> (2 * g_), row0_ = ((IT) & 255) * 256, s0_ = row0_ & ~(Lg_ - 1), m0_ = row0_ - s0_; \
        const size_t off_ = (size_t)g_ * NT * 256 + j_ * 64
    u32x4 kr[3], vr[3]; bf16x8 qf[4];
#define AT_LOAD(s0_, m0_, Lg_, off_, row0_) do { _Pragma("unroll") for (int i = 0; i < 3; ++i) { int kk_ = (m0_) - 64 + prow + 128 * i; kk_ = kk_ < 0 ? 0 : (kk_ > (Lg_) - 1 ? (Lg_) - 1 : kk_); \
            const size_t o_ = (off_) + (size_t)((s0_) + kk_) * 256 + 16 * pc4; kr[i] = *(const u32x4*)(K8 + o_); vr[i] = *(const u32x4*)(V8 + o_); } \
        _Pragma("unroll") for (int s = 0; s < 4; ++s) qf[s] = *(const bf16x8*)(QG + (off_) + (size_t)((row0_) + 32 * w + r31) * 256 + 16 * s + 8 * h); } while (0)
    const int it0 = F.vcu + k0 * F.G, itE = (F.vcu + (long)k1 * F.G < NITEM) ? F.vcu + k1 * F.G : NITEM;
    if (it0 < itE) { AT_DECODE(it0, g, j, Lg, row0, s0, m0, off); AT_LOAD(s0, m0, Lg, off, row0); }
    for (int it = it0; it < itE; it += F.G) {
        AT_DECODE(it, g, j, Lg, row0, s0, m0, off);
        __syncthreads();
#pragma unroll
        for (int i = 0; i < 3; ++i) { u32x4 a0, a1, b0, b1; expand_fp8x16(kr[i], a0, a1); expand_fp8x16(vr[i], b0, b1);
            LAS unsigned char* kd = kl + (prow + 128 * i) * VPITCH + 32 * pc4; LAS unsigned char* vd = vl + (prow + 128 * i) * VPITCH + 32 * pc4;
            *(LAS u32x4*)(kd) = a0; *(LAS u32x4*)(kd + 16) = a1; *(LAS u32x4*)(vd) = b0; *(LAS u32x4*)(vd + 16) = b1; }
        bf16x8 qc[4];
#pragma unroll
        for (int s = 0; s < 4; ++s) qc[s] = qf[s];
        __syncthreads();
        { const int itn = it + F.G; if (itn < itE) { AT_DECODE(itn, gn, jn, Lgn, row0n, s0n, m0n, offn); AT_LOAD(s0n, m0n, Lgn, offn, row0n); } }
        f32x16 st[5];
        float mx = -3.0e38f;
#pragma unroll
        for (int kt = 0; kt < 5; ++kt) {
            const int kb = m0 - 64 + 32 * (w + kt);
            bf16x8 kc[4];
#pragma unroll
            for (int s = 0; s < 4; ++s) kc[s] = *(const LAS bf16x8*)(kl + (32 * (w + kt) + r31) * VPITCH + (16 * s + 8 * h) * 2);
            f32x16 a;
#pragma unroll
            for (int i = 0; i < 16; ++i) a[i] = 0.f;
#pragma unroll
            for (int s = 0; s < 4; ++s) a = __builtin_amdgcn_mfma_f32_32x32x16_bf16(kc[s], qc[s], a, 0, 0, 0);
#pragma unroll
            for (int i = 0; i < 16; ++i) {
                const int key = kb + (i & 3) + 8 * (i >> 2) + 4 * h;
                const int dq = key - (m0 + 32 * w + r31);
                const bool ok = (key >= 0) && (key < Lg) && (dq <= 64) && (dq >= -64);
                a[i] = ok ? a[i] : -1.0e30f;
                mx = fmaxf(mx, a[i]);
            }
            st[kt] = a;
        }
        mx = fmaxf(mx, __shfl_xor(mx, 32));
        float lsum = 0.f;
#pragma unroll
        for (int kt = 0; kt < 5; ++kt)
#pragma unroll
            for (int i = 0; i < 16; ++i) { const float p = fast_exp2(st[kt][i] - mx); st[kt][i] = p; lsum += p; }
        lsum += __shfl_xor(lsum, 32);
        f32x16 o0, o1;
#pragma unroll
        for (int i = 0; i < 16; ++i) { o0[i] = 0.f; o1[i] = 0.f; }
#pragma unroll
        for (int kt = 0; kt < 5; ++kt) {
            const LAS unsigned char* vt = vl + 32 * (w + kt) * VPITCH;
#pragma unroll
            for (int s2 = 0; s2 < 2; ++s2) {
                u32x4 pp; pp.x = cvt_pk_bf16(st[kt][8 * s2], st[kt][8 * s2 + 1]); pp.y = cvt_pk_bf16(st[kt][8 * s2 + 2], st[kt][8 * s2 + 3]);
                pp.z = cvt_pk_bf16(st[kt][8 * s2 + 4], st[kt][8 * s2 + 5]); pp.w = cvt_pk_bf16(st[kt][8 * s2 + 6], st[kt][8 * s2 + 7]);
                const bf16x8 pf = __builtin_bit_cast(bf16x8, pp);
#pragma unroll
                for (int dt = 0; dt < 2; ++dt) {
                    const LAS unsigned char* base = vt + (16 * s2 + 4 * h + tq) * VPITCH + (32 * dt + 16 * dblk + 4 * tp) * 2;
                    const s16x4 lo = vtr(base), hi = vtr(base + 8 * VPITCH);
                    const bf16x8 vf = __builtin_shufflevector(lo, hi, 0, 1, 2, 3, 4, 5, 6, 7);
                    if (dt == 0) o0 = __builtin_amdgcn_mfma_f32_32x32x16_bf16(vf, pf, o0, 0, 0, 0);
                    else o1 = __builtin_amdgcn_mfma_f32_32x32x16_bf16(vf, pf, o1, 0, 0, 0);
                }
            }
        }
        const float inv = fast_rcp(lsum);
        LAS unsigned char* ot = F.lds + AT_O + w * (32 * VPITCH);
#pragma unroll
        for (int q = 0; q < 4; ++q) {
            u32x2 w0, w1;
            w0.x = cvt_pk_bf16(o0[4 * q] * inv, o0[4 * q + 1] * inv); w0.y = cvt_pk_bf16(o0[4 * q + 2] * inv, o0[4 * q + 3] * inv);
            w1.x = cvt_pk_bf16(o1[4 * q] * inv, o1[4 * q + 1] * inv); w1.y = cvt_pk_bf16(o1[4 * q + 2] * inv, o1[4 * q + 3] * inv);
            *(LAS u32x2*)(ot + r31 * VPITCH + (8 * q + 4 * h) * 2) = w0; *(LAS u32x2*)(ot + r31 * VPITCH + (32 + 8 * q + 4 * h) * 2) = w1;
        }
        LDS_WAIT();
        {
            bf16_t* ob = OG + off + (size_t)(row0 + 32 * w) * 256;
#pragma unroll
            for (int i = 0; i < 4; ++i) { const int c = lane + 64 * i, rr = c >> 3, c8 = c & 7; *(u32x4*)(ob + (size_t)rr * 256 + 8 * c8) = *(const LAS u32x4*)(ot + rr * VPITCH + 16 * c8); }
        }
        if (h == 0) LSE[((size_t)g * NT + row0 + 32 * w + r31) * 4 + j] = LN2 * (mx + __builtin_amdgcn_logf(lsum));
    }
#undef AT_DECODE
#undef AT_LOAD
}

__device__ __forceinline__ void phase_combine(const Frame& F, const Ptrs& P) {
    const bf16_t* OG = (const bf16_t*)((unsigned char*)P.out + DO_OG); const float* LSE = (const float*)(P.ws + WS_LSE);
    bf16_t* AT = (bf16_t*)(P.ws + WS_ATTN);
    const int gw = F.vcu * NWAVES + F.wave, NGW = F.G * NWAVES, j = F.lane >> 4;
    for (int rb = gw; rb < NT; rb += 4 * NGW) {
        float l[4][3]; u32x2 o[4][3];
#pragma unroll
        for (int q = 0; q < 4; ++q) { const int r = rb + q * NGW;
            if (r < NT) {
#pragma unroll
                for (int g = 0; g < 3; ++g) { const int rp = perm_row(r, 2 * g); l[q][g] = LSE[((size_t)g * NT + rp) * 4 + j]; o[q][g] = *(const u32x2*)(OG + ((size_t)g * NT + rp) * 256 + 4 * F.lane); } } }
#pragma unroll
        for (int q = 0; q < 4; ++q) { const int r = rb + q * NGW;
            if (r < NT) {
                const float m = fmaxf(l[q][0], fmaxf(l[q][1], l[q][2]));
                float w[3]; float s = 0.f;
#pragma unroll
                for (int g = 0; g < 3; ++g) { w[g] = fast_exp2((l[q][g] - m) * LOG2E); s += w[g]; }
                const float inv = fast_rcp(s);
                float a0 = 0.f, a1 = 0.f, a2 = 0.f, a3 = 0.f;
#pragma unroll
                for (int g = 0; g < 3; ++g) { const float ww = w[g] * inv; a0 += ww * bflo(o[q][g].x); a1 += ww * bfhi(o[q][g].x); a2 += ww * bflo(o[q][g].y); a3 += ww * bfhi(o[q][g].y); }
                u32x2 pk; pk.x = cvt_pk_bf16(a0, a1); pk.y = cvt_pk_bf16(a2, a3);
                *(u32x2*)(AT + (size_t)r * 256 + 4 * F.lane) = pk;
            } }
    }
}

constexpr int TPITCH = 144;
constexpr int LRU_XRT = 0;
constexpr int LRU_XC = 37376;
constexpr int LRU_OUT = 74240;
constexpr int LRU_W = 111104;
constexpr int LRU_CMP = 129536;
constexpr int LRU_CARRY = 133632;
constexpr int LRU_CONV = 134144;
__device__ __forceinline__ int probe_reps(bool on) { int n = on ? 2 : 1; asm volatile("" : "+s"(n)); return n; }
__device__ __forceinline__ void probe_fence() { asm volatile("" ::: "memory"); }
#ifdef LRU_PROBE_STAGE
#define LRU_PROBE_LOOP(k) _Pragma("nounroll") for (int rep_ = 0, nrep_ = probe_reps((k) == LRU_PROBE_STAGE); rep_ < nrep_; ++rep_, probe_fence())
#else
#define LRU_PROBE_LOOP(k)
#endif
template <bool B> struct BoolC { static constexpr bool value = B; };
constexpr int LT_TOK = 128;
constexpr int LT_XRT = 0, LT_XC = 20224, LT_OUT = LT_XC + 18432, LT_W = LT_OUT + 18432, LT_CMP = LT_W + 18432, LT_CARRY = LT_CMP + 2048, LT_CONV = LT_CARRY + 512, LT_SIZE = LT_CONV + 640;
static_assert(2 * LT_SIZE <= 163840 - 256, "LRU LDS");
template <int DIR>
__device__ __forceinline__ void lru_team(const Frame& F, const Ptrs& P, int b, int blk) {
    const bf16_t* XR = (const bf16_t*)(P.ws + WS_XR); const bf16_t* GY = (const bf16_t*)(P.ws + WS_GY);
    bf16_t* HF = (bf16_t*)((unsigned char*)P.out + DO_HF); bf16_t* LR = (bf16_t*)(P.ws + WS_LRU);
    const bf16_t* WL = (const bf16_t*)(P.ws + WS_WLRU) + (size_t)((DIR * 16 + blk) * 2) * 4096;
    LAS unsigned char* tb_ = F.lds + DIR * LT_SIZE;
    LAS unsigned char* xrt = tb_ + LT_XRT + (F.wave & 3) * 35 * TPITCH; LAS unsigned char* xcb = tb_ + LT_XC; LAS unsigned char* outt = tb_ + LT_OUT; LAS unsigned char* wl = tb_ + LT_W;
    LAS float* cmp = (LAS float*)(tb_ + LT_CMP); LAS float* carry = (LAS float*)(tb_ + LT_CARRY); LAS unsigned char* cvb = tb_ + LT_CONV;
    const int lane = F.lane, r31 = lane & 31, h = lane >> 5, w = F.wave & 3, ttid = F.tid & 255;
    const int ch0 = blk * 64, cc = lane & 7, tl0 = 32 * w + (lane >> 3);
    const size_t gcol = (size_t)ch0 + 8 * cc;
    for (int i = ttid; i < 1024; i += 256) { const int row = i >> 3, ch8 = i & 7; *(LAS u32x4*)(wl + row * TPITCH + 16 * ch8) = *(const u32x4*)(WL + (size_t)row * 64 + 8 * ch8); }
    for (int i = ttid; i < 320; i += 256) { const int jj = i >> 6, ch = i & 63; *(LAS _Float16*)(cvb + i * 2) = (_Float16)(jj < 4 ? P.conv_w[jj * 1024 + ch0 + ch] : P.conv_b[ch0 + ch]); }
    if (ttid < 128) carry[ttid] = 0.f;
    float ba[2], bx[2], cl[2];
#pragma unroll
    for (int c2 = 0; c2 < 2; ++c2) { const int ch = ch0 + 32 * c2 + r31;
        ba[c2] = -LOG2E * P.lru_b_a[DIR * 1024 + ch]; bx[c2] = -LOG2E * P.lru_b_x[DIR * 1024 + ch];
        const float lam = P.lru_lambda[DIR * 1024 + ch];
        const float sp = (lam > 15.f) ? __expf(-lam) : ((lam < -15.f) ? -lam : log1pf(__expf(-lam)));
        cl[c2] = -8.0f * sp * LOG2E; }
    u32x4 xrp[4], xrh = (u32x4){0u, 0u, 0u, 0u}, hfp[4], gyp[4];
#define LRU_LOAD_XR(T0) do { _Pragma("unroll") for (int i = 0; i < 4; ++i) xrp[i] = *(const u32x4*)(XR + (size_t)(b * SEQ + (T0) + tl0 + 8 * i) * 1024 + gcol); \
        int tz_ = lane; asm volatile("" : "+v"(tz_));     \
        if (tz_ < 24) { const int hr = tz_ >> 3; const int th = hr < 2 ? (T0) + 32 * w - 2 + hr : (T0) + 32 * w + 32; xrh = (u32x4){0u, 0u, 0u, 0u}; if (th >= 0 && th < SEQ) xrh = *(const u32x4*)(XR + (size_t)(b * SEQ + th) * 1024 + ch0 + 8 * (tz_ & 7)); } } while (0)
#define LRU_LOAD_HG(T0) do { _Pragma("unroll") for (int i = 0; i < 4; ++i) { const size_t o = (size_t)(b * SEQ + (T0) + tl0 + 8 * i) * 1024 + gcol; hfp[i] = *(const u32x4*)(HF + o); gyp[i] = *(const u32x4*)(GY + o); } } while (0)
#define LRU_XR_TO_LDS() do { _Pragma("unroll") for (int i = 0; i < 4; ++i) *(LAS u32x4*)(xrt + ((lane >> 3) + 8 * i + 2) * TPITCH + 16 * cc) = xrp[i]; \
        int tz_ = lane; asm volatile("" : "+v"(tz_)); if (tz_ < 24) { const int hr = tz_ >> 3; *(LAS u32x4*)(xrt + (hr < 2 ? hr : 34) * TPITCH + 16 * (tz_ & 7)) = xrh; } } while (0)
    auto conv_stage = [&]() __attribute__((always_inline)) {
        int ln_ = F.lane; asm volatile("" : "+v"(ln_));
        const int lane = ln_, cc = lane & 7, tl0 = 32 * w + (lane >> 3);
        LRU_PROBE_LOOP(3)
        {
            u32x4 cwv[5];
#pragma unroll
            for (int jj = 0; jj < 5; ++jj) cwv[jj] = *(const LAS u32x4*)(cvb + jj * 128 + 16 * cc);
#pragma unroll
            for (int ih = 0; ih < 2; ++ih) {
                u32x4 xv[2][4];
#pragma unroll
                for (int i = 0; i < 2; ++i)
#pragma unroll
                    for (int jj = 0; jj < 4; ++jj) xv[i][jj] = *(const LAS u32x4*)(xrt + ((lane >> 3) + 8 * (2 * ih + i) + jj) * TPITCH + 16 * cc);
                __builtin_amdgcn_sched_barrier(0);
#pragma unroll
                for (int i = 0; i < 2; ++i) {
                    h16x2 x0 = ash2(cwv[4].x), x1 = ash2(cwv[4].y), x2 = ash2(cwv[4].z), x3 = ash2(cwv[4].w);
#pragma unroll
                    for (int jj = 0; jj < 4; ++jj) {
                        x0 = ash2(cwv[jj].x) * ash2(xv[i][jj].x) + x0; x1 = ash2(cwv[jj].y) * ash2(xv[i][jj].y) + x1; x2 = ash2(cwv[jj].z) * ash2(xv[i][jj].z) + x2; x3 = ash2(cwv[jj].w) * ash2(xv[i][jj].w) + x3;
                    }
                    *(LAS u32x4*)(xcb + (tl0 + 8 * (2 * ih + i)) * TPITCH + 16 * cc) = (u32x4){asu(x0), asu(x1), asu(x2), asu(x3)};
                }
                __builtin_amdgcn_sched_barrier(0);
            }
        }
    };
    { const int t00 = DIR ? SEQ - LT_TOK : 0; LRU_LOAD_XR(t00); }
    __syncthreads();
    LRU_XR_TO_LDS();
    conv_stage();
    __syncthreads();
    if (DIR) __syncthreads();
    auto step_body = [&](const int step, auto sec_) __attribute__((always_inline)) {
        int ln_ = F.lane; asm volatile("" : "+v"(ln_));
        const int lane = ln_, r31 = lane & 31, h = lane >> 5, ttid = 64 * w + lane, cc = lane & 7, tl0 = 32 * w + (lane >> 3);
        const size_t gcol = (size_t)ch0 + 8 * cc;
        const int t0 = DIR ? (SEQ - LT_TOK - LT_TOK * step) : LT_TOK * step;
        const int t0n = DIR ? t0 - LT_TOK : t0 + LT_TOK;
        constexpr bool second = decltype(sec_)::value;
        if (step < SEQ / LT_TOK - 1) LRU_LOAD_XR(t0n);
        const int tw = 32 * w;
        h16x8 af[4];
#pragma unroll
        for (int s = 0; s < 4; ++s) af[s] = *(const LAS h16x8*)(xcb + (tw + r31) * TPITCH + (16 * s + 8 * h) * 2);
        float av[2][16], uv[2][16], A0[2], U0[2], A1[2], U1[2];
        LRU_PROBE_LOOP(4)
#pragma unroll
        for (int c2 = 0; c2 < 2; ++c2) {
            f32x16 za, zx;
#pragma unroll
            for (int i = 0; i < 16; ++i) { za[i] = ba[c2]; zx[i] = bx[c2]; }
#pragma unroll
            for (int s = 0; s < 4; ++s) {
                const h16x8 wa = *(const LAS h16x8*)(wl + (32 * c2 + r31) * TPITCH + (16 * s + 8 * h) * 2), wx = *(const LAS h16x8*)(wl + (64 + 32 * c2 + r31) * TPITCH + (16 * s + 8 * h) * 2);
                za = __builtin_amdgcn_mfma_f32_32x32x16_f16(af[s], wa, za, 0, 0, 0); zx = __builtin_amdgcn_mfma_f32_32x32x16_f16(af[s], wx, zx, 0, 0, 0);
            }
            f32x16 xcv;
#pragma unroll
            for (int i = 0; i < 16; ++i) xcv[i] = 0.f;
            {   h16x8 sel0, sel1;
#pragma unroll
                for (int j = 0; j < 8; ++j) { sel0[j] = (8 * h + j == r31) ? (_Float16)1.0f : (_Float16)0.0f; sel1[j] = (16 + 8 * h + j == r31) ? (_Float16)1.0f : (_Float16)0.0f; }
                xcv = __builtin_amdgcn_mfma_f32_32x32x16_f16(af[2 * c2], sel0, xcv, 0, 0, 0); xcv = __builtin_amdgcn_mfma_f32_32x32x16_f16(af[2 * c2 + 1], sel1, xcv, 0, 0, 0); }
#pragma unroll
            for (int i = 0; i < 16; ++i) { za[i] = fast_exp2(za[i]); zx[i] = fast_exp2(zx[i]); }
            __builtin_amdgcn_sched_barrier(0);
#pragma unroll
            for (int i = 0; i < 16; ++i) { za[i] = fast_rcp(1.0f + za[i]); zx[i] = fast_rcp(1.0f + zx[i]); }
            __builtin_amdgcn_sched_barrier(0);
#pragma unroll
            for (int i = 0; i < 16; ++i) za[i] = fast_exp2(cl[c2] * za[i]);
            __builtin_amdgcn_sched_barrier(0);
#pragma unroll
            for (int i = 0; i < 16; ++i) zx[i] = __builtin_amdgcn_sqrtf(__builtin_fmaf(-za[i], za[i], 1.0f)) * (zx[i] * xcv[i]);
            __builtin_amdgcn_sched_barrier(0);
#pragma unroll
            for (int q = 0; q < 2; ++q)
#pragma unroll
                for (int j = 0; j < 4; ++j) {
                    const int i = 4 * q + j;
                    const auto ra = __builtin_amdgcn_permlane32_swap(__float_as_uint(za[i]), __float_as_uint(za[i + 8]), false, false);
                    const auto ru = __builtin_amdgcn_permlane32_swap(__float_as_uint(zx[i]), __float_as_uint(zx[i + 8]), false, false);
                    av[c2][8 * q + j] = __uint_as_float(ra[0]); av[c2][8 * q + 4 + j] = __uint_as_float(ra[1]);
                    uv[c2][8 * q + j] = __uint_as_float(ru[0]); uv[c2][8 * q + 4 + j] = __uint_as_float(ru[1]);
                }
            float A = 1.f, U = 0.f;
#pragma unroll
            for (int e = 0; e < 16; ++e) { const int k = DIR ? 15 - e : e; U = U * av[c2][k] + uv[c2][k]; A *= av[c2][k]; }
            { const auto rA = __builtin_amdgcn_permlane32_swap(__float_as_uint(A), __float_as_uint(A), false, false); A0[c2] = __uint_as_float(rA[0]); A1[c2] = __uint_as_float(rA[1]);
              const auto rU = __builtin_amdgcn_permlane32_swap(__float_as_uint(U), __float_as_uint(U), false, false); U0[c2] = __uint_as_float(rU[0]); U1[c2] = __uint_as_float(rU[1]); }
            const float tA = A0[c2] * A1[c2], tU = DIR ? (U1[c2] * A0[c2] + U0[c2]) : (U0[c2] * A1[c2] + U1[c2]);
            if (h == 0) { cmp[(w * 64 + 32 * c2 + r31) * 2] = tA; cmp[(w * 64 + 32 * c2 + r31) * 2 + 1] = tU; }
            asm volatile("" ::: "memory");
        }
        __syncthreads();
        if (second) LRU_LOAD_HG(t0);
        LRU_PROBE_LOOP(5)
#pragma unroll
        for (int c2 = 0; c2 < 2; ++c2) {
            const int ch = 32 * c2 + r31;
            float Hc = carry[(step & 1) * 64 + ch];
            float Hin = Hc;
#pragma unroll
            for (int k = 0; k < 4; ++k) {
                const int ww = DIR ? 3 - k : k;
                const f32x2 cu = *(const LAS f32x2*)(cmp + (ww * 64 + ch) * 2);
                const bool before = DIR ? (ww > w) : (ww < w);
                if (before) Hin = Hin * cu[0] + cu[1];
                Hc = Hc * cu[0] + cu[1];
            }
            if (w == 0 && h == 0) carry[((step + 1) & 1) * 64 + ch] = Hc;
            float hv = DIR ? (h == 1 ? Hin : Hin * A1[c2] + U1[c2]) : (h == 0 ? Hin : Hin * A0[c2] + U0[c2]);
#pragma unroll
            for (int e = 0; e < 16; ++e) {
                const int k = DIR ? 15 - e : e;
                hv = hv * av[c2][k] + uv[c2][k];
                *(LAS _Float16*)(outt + (tw + 16 * h + k) * TPITCH + ch * 2) = (_Float16)hv;
            }
            asm volatile("" ::: "memory");
        }
        LRU_PROBE_LOOP(6)
#pragma unroll
        for (int i = 0; i < 4; ++i) {
            const int tl = tl0 + 8 * i; const size_t o = (size_t)(b * SEQ + t0 + tl) * 1024 + gcol;
            const u32x4 hb = *(const LAS u32x4*)(outt + tl * TPITCH + 16 * cc);
            if (!second) *(u32x4*)(HF + o) = hb;
            else {
                const h16x2 p0 = (ash2(hb.x) + ash2(hfp[i].x)) * ash2(gyp[i].x), p1 = (ash2(hb.y) + ash2(hfp[i].y)) * ash2(gyp[i].y), p2 = (ash2(hb.z) + ash2(hfp[i].z)) * ash2(gyp[i].z), p3 = (ash2(hb.w) + ash2(hfp[i].w)) * ash2(gyp[i].w);
                u32x4 ov; ov.x = cvt_pk_bf16((float)p0[0], (float)p0[1]); ov.y = cvt_pk_bf16((float)p1[0], (float)p1[1]); ov.z = cvt_pk_bf16((float)p2[0], (float)p2[1]); ov.w = cvt_pk_bf16((float)p3[0], (float)p3[1]);
                *(u32x4*)(LR + o) = ov;
            }
        }
        if (step == SEQ / LT_TOK / 2 - 1) VM_WAIT();
        if (step < SEQ / LT_TOK - 1) { LRU_XR_TO_LDS(); conv_stage(); }
        __syncthreads();
    };
#pragma nounroll
    for (int step = 0; step < SEQ / LT_TOK / 2; ++step) step_body(step, BoolC<false>{});
#pragma nounroll
    for (int step = SEQ / LT_TOK / 2; step < SEQ / LT_TOK; ++step) step_body(step, BoolC<true>{});
    if (!DIR) __syncthreads();
#undef LRU_XR_TO_LDS
#undef LRU_LOAD_XR
#undef LRU_LOAD_HG
}
__device__ __forceinline__ void phase_lru(const Frame& F, const Ptrs& P) {
    for (int u = F.vcu; u < 256; u += F.G) {
        const int b = u >> 4, blk = u & 15;
        if (F.wave < 4) lru_team<0>(F, P, b, blk); else lru_team<1>(F, P, b, blk);
        __syncthreads();
    }
}

#ifdef H2_PROBE_STAGE
#define H2_PROBE_LOOP(k) _Pragma("nounroll") for (int rep_ = 0, nrep_ = probe_reps((k) == H2_PROBE_STAGE); rep_ < nrep_; ++rep_, probe_fence())
#else
#define H2_PROBE_LOOP(k)
#endif
constexpr int H2_RED = 0;
constexpr int H2_SSQ = 16384;
constexpr int H2_BIAS = 17408;
constexpr int H2_AFF = 18432;
constexpr int H2_F8T = 35328;
constexpr int H2_CS = 53760;
constexpr int H2_XT = 65536;
__device__ __forceinline__ void phase_h2(const Frame& F, const Ptrs& P, unsigned char* H2) {
    const float* mod = (const float*)(P.ws + WS_MOD);
    float* AFF = (float*)(P.ws + WS_AFF);
    convert_expert_items(F, P, EXPERT_ITEMS_ALL, 1 << 20);
    __syncthreads();
    LAS float* red = (LAS float*)(F.lds + H2_RED); LAS float* ssq = (LAS float*)(F.lds + H2_SSQ); LAS float* biasp = (LAS float*)(F.lds + H2_BIAS); LAS float* affl = (LAS float*)(F.lds + H2_AFF);
    LAS unsigned char* f8t = F.lds + H2_F8T + F.wave * 2304;
    LAS unsigned char* xt = F.lds + H2_XT + F.wave * 8192;
    const int l = F.lane, r = l & 15, kq = l >> 4, w = F.wave;
    LAS f32x4* csl = (LAS f32x4*)(F.lds + H2_CS) + (w * 4 + kq) * 8;
    const int kb = 128 * w + 4 * kq;
    const int lrow = l >> 5, lq = l & 31;
    H2_PROBE_LOOP(2)
    for (int rb = F.vcu; rb < NT / 256; rb += F.G) {
        const int R0 = rb * 256, b = R0 >> 12, tb = R0 & 4095;
        f32x4 wB[8];
        float pb = 0.f;
#pragma unroll
        for (int jh = 0; jh < 2; ++jh) {
            f32x4 nw[4], sc[4], shv[4]; float wrv[4][4];
            const float* wb = P.w_router + (size_t)(kb + 64 * jh) * 16 + r; asm volatile("" : "+v"(wb));
#pragma unroll
            for (int j4 = 0; j4 < 4; ++j4) { const int j = 4 * jh + j4, k = kb + 16 * j; nw[j4] = *(const f32x4*)(P.norm2_w + k); sc[j4] = *(const f32x4*)(mod + b * 6144 + 4096 + k); shv[j4] = *(const f32x4*)(mod + b * 6144 + 3072 + k);
#pragma unroll
                for (int c = 0; c < 4; ++c) wrv[j4][c] = wb[(16 * j4 + c) * 16]; }
#pragma unroll
            for (int j4 = 0; j4 < 4; ++j4) { const int j = 4 * jh + j4; const f32x4 cmv = nw[j4] * (sc[j4] + 1.0f);
                if (r == 0) { csl[j] = cmv; csl[256 + j] = shv[j4]; }
#pragma unroll
                for (int c = 0; c < 4; ++c) { pb += shv[j4][c] * wrv[j4][c]; wB[j][c] = cmv[c] * wrv[j4][c]; } }
            asm volatile("" ::: "memory");
        }
        pb += __shfl_xor(pb, 16); pb += __shfl_xor(pb, 32);
        if (l < 16) biasp[w * 16 + l] = pb;
        f32x4 xa[8], xb[8];
        const float* xbase = P.out + (size_t)(R0 + lrow) * DM + 128 * w + 4 * lq;
#define H2_LOAD(dst, g_) do { _Pragma("unroll") for (int i = 0; i < 8; ++i) dst[i] = *(const f32x4*)(xbase + (size_t)(16 * (g_) + 2 * i) * DM); } while (0)
#define H2_TILE(xr_) do { _Pragma("unroll") for (int i = 0; i < 8; ++i) { const int row = 2 * i + lrow; *(LAS f32x4*)(xt + row * 512 + 16 * (lq ^ row)) = xr_[i]; } } while (0)
        H2_LOAD(xa, 0); H2_LOAD(xb, 1);
        H2_TILE(xa); H2_LOAD(xa, 2);
        __syncthreads();
        float bias_e = 0.f;
#pragma unroll
        for (int w2 = 0; w2 < 8; ++w2) bias_e += biasp[w2 * 16 + r];
          \
#define H2_GROUP(g, xn_) do { \
            f32x4 xv[8]; \
            _Pragma("unroll") for (int j = 0; j < 8; ++j) xv[j] = *(const LAS f32x4*)(xt + r * 512 + 16 * ((4 * j + kq) ^ r)); \
            float s = 0.f; f32x4 acc = (f32x4){0.f, 0.f, 0.f, 0.f}; \
            _Pragma("unroll") for (int j = 0; j < 8; ++j) \
                _Pragma("unroll") for (int c = 0; c < 4; ++c) { s = __builtin_fmaf(xv[j][c], xv[j][c], s); acc = __builtin_amdgcn_mfma_f32_16x16x4f32(xv[j][c], wB[j][c], acc, 0, 0, 0); } \
            s += __shfl_xor(s, 16); s += __shfl_xor(s, 32); \
            const int par = (g) & 1; \
            _Pragma("unroll") for (int i = 0; i < 4; ++i) red[(par * 8 + w) * 256 + (4 * kq + i) * 16 + r] = acc[i];         \
            if (kq == 0) ssq[(par * 16 + r) * 8 + w] = s; \
            __syncthreads(); \
              \
            { const f32x4 s0 = *(const LAS f32x4*)(ssq + (par * 16 + r) * 8), s1 = *(const LAS f32x4*)(ssq + (par * 16 + r) * 8 + 4); \
              const float rinv = __builtin_amdgcn_rsqf(((s0[0] + s0[1]) + (s0[2] + s0[3]) + (s1[0] + s1[1]) + (s1[2] + s1[3])) * (1.0f / DM) + NORM_EPS); \
              _Pragma("unroll") for (int j = 0; j < 8; ++j) { const f32x4 hv = xv[j] * rinv * csl[j] + csl[256 + j]; *(LAS unsigned*)(f8t + r * 144 + 16 * j + 4 * kq) = pk4_fp8(hv[0], hv[1], hv[2], hv[3]); } } \
            { const u32x4 o0 = *(const LAS u32x4*)(f8t + (l >> 2) * 144 + 32 * (l & 3)), o1 = *(const LAS u32x4*)(f8t + (l >> 2) * 144 + 32 * (l & 3) + 16); \
              unsigned char* dst = H2 + (size_t)(R0 + 16 * (g) + (l >> 2)) * DM + 128 * w + 32 * (l & 3); \
              *(u32x4*)dst = o0; *(u32x4*)(dst + 16) = o1; } \
              \
            { const int rr = 2 * w + ((l >> 4) & 1); \
              float lg = 0.f; \
              _Pragma("unroll") for (int w2 = 0; w2 < 8; ++w2) lg += red[(par * 8 + w2) * 256 + rr * 16 + r]; \
              const f32x4 s0 = *(const LAS f32x4*)(ssq + (par * 16 + rr) * 8), s1 = *(const LAS f32x4*)(ssq + (par * 16 + rr) * 8 + 4); \
              const float rinv = __builtin_amdgcn_rsqf(((s0[0] + s0[1]) + (s0[2] + s0[3]) + (s1[0] + s1[1]) + (s1[2] + s1[3])) * (1.0f / DM) + NORM_EPS); \
              lg = lg * rinv + bias_e; \
              float m = lg; \
              _Pragma("unroll") for (int o2 = 1; o2 < 16; o2 <<= 1) m = fmaxf(m, __shfl_xor(m, o2)); \
              const float pe = fast_exp2((lg - m) * LOG2E); \
              float sm = pe; \
              _Pragma("unroll") for (int o2 = 1; o2 < 16; o2 <<= 1) sm += __shfl_xor(sm, o2); \
              if (l < 32) affl[r * 260 + 16 * (g) + rr] = pe / sm; } \
            H2_TILE(xn_); \
            { const int gl_ = (g) + 3 < 16 ? (g) + 3 : 15; H2_LOAD(xn_, gl_); } \
        } while (0)
#pragma nounroll
        for (int g = 0; g < 16; g += 2) { H2_GROUP(g, xb); H2_GROUP(g + 1, xa); }
#undef H2_GROUP
#undef H2_TILE
#undef H2_LOAD
        __syncthreads();
        { const int e = F.tid >> 5, t8 = (F.tid & 31) * 8;
          const f32x4 v0 = *(const LAS f32x4*)(affl + e * 260 + t8), v1 = *(const LAS f32x4*)(affl + e * 260 + t8 + 4);
          float* d = AFF + (size_t)(b * 16 + e) * SEQ + tb + t8; *(f32x4*)d = v0; *(f32x4*)(d + 4) = v1; }
    }
}

__device__ __forceinline__ void phase_topk(const Frame& F, const Ptrs& P) {
    const float* AFF = (const float*)(P.ws + WS_AFF); float* GTS = (float*)(P.ws + WS_GTS); short* SLOT = (short*)(P.ws + WS_SLOT);
    LAS unsigned* vals = (LAS unsigned*)F.lds;
    LAS unsigned* hist = (LAS unsigned*)(F.lds + 16384);
    LAS unsigned* sel = (LAS unsigned*)(F.lds + 16384 + 1024);
    LAS unsigned* wsum = (LAS unsigned*)(F.lds + 16384 + 1024 + 64);
    LAS unsigned* wtot = (LAS unsigned*)(F.lds + 16384 + 1024 + 32);
    unsigned short* IDX = (unsigned short*)(P.ws + WS_IDX);
    for (int u = F.vcu; u < 256; u += F.G) {
        const int b = u >> 4, e = u & 15;
        const float* av = AFF + (size_t)(b * 16 + e) * SEQ;
        unsigned v[8];
        { const u32x4 a = *(const u32x4*)(av + 8 * F.tid), c = *(const u32x4*)(av + 8 * F.tid + 4);
          v[0] = a.x; v[1] = a.y; v[2] = a.z; v[3] = a.w; v[4] = c.x; v[5] = c.y; v[6] = c.z; v[7] = c.w; }
        unsigned prefix = 0u, mask = 0u, kk = CAP;
        for (int pass = 0; pass < 4; ++pass) {
            const int shift = 24 - 8 * pass;
            if (F.tid < 256) hist[F.tid] = 0u;
            __syncthreads();
#pragma unroll
            for (int i = 0; i < 8; ++i) if ((v[i] & mask) == prefix) atomicAdd((unsigned*)&hist[(v[i] >> shift) & 255u], 1u);
            __syncthreads();
            unsigned mine = 0u, inc = 0u;
            if (F.tid < 256) {
                mine = hist[F.tid]; inc = mine;
#pragma unroll
                for (int o2 = 1; o2 < 64; o2 <<= 1) { const unsigned n = __shfl_down(inc, o2); if (F.lane + o2 < 64) inc += n; }
                if (F.lane == 0) wtot[F.wave] = inc;
            }
            __syncthreads();
            if (F.tid < 256) {
                unsigned sfx = inc - mine;
                for (int w2 = F.wave + 1; w2 < 4; ++w2) sfx += wtot[w2];
                if (sfx < kk && sfx + mine >= kk) { sel[0] = (unsigned)F.tid; sel[1] = kk - sfx; }
            }
            __syncthreads();
            prefix |= sel[0] << shift; mask |= 255u << shift; kk = sel[1];
            __syncthreads();
        }
        const unsigned T = prefix;
        unsigned cg = 0u, ce = 0u;
#pragma unroll
        for (int i = 0; i < 8; ++i) { cg += (v[i] > T) ? 1u : 0u; ce += (v[i] == T) ? 1u : 0u; }
        unsigned pk = cg | (ce << 16), inc = pk;
#pragma unroll
        for (int o2 = 1; o2 < 64; o2 <<= 1) { const unsigned n = __shfl_up(inc, o2); if (F.lane >= o2) inc += n; }
        if (F.lane == 63) wsum[F.wave] = inc;
        __syncthreads();
        unsigned base = 0u;
        for (int w2 = 0; w2 < F.wave; ++w2) base += wsum[w2];
        unsigned excl = base + inc - pk;
        unsigned ng = excl & 0xffffu, neq = excl >> 16;
        short sl[8];
#pragma unroll
        for (int i = 0; i < 8; ++i) {
            if (v[i] > T) { sl[i] = (short)(ng + (neq < kk ? neq : kk)); ++ng; }
            else if (v[i] == T) { sl[i] = (neq < kk) ? (short)(ng + neq) : (short)-1; ++neq; }
            else sl[i] = (short)-1;
        }
#pragma unroll
        for (int i = 0; i < 8; ++i) {
            const int t = 8 * F.tid + i;
            SLOT[(size_t)e * NT + b * SEQ + t] = sl[i];
            if (sl[i] >= 0) { IDX[(size_t)(e * 16 + b) * 512 + sl[i]] = (unsigned short)t; GTS[(size_t)e * 8192 + b * 512 + sl[i]] = __uint_as_float(v[i]); }
        }
        __syncthreads();
    }
}

__device__ __forceinline__ void phase_final(const Frame& F, const Ptrs& P, const unsigned char* YS) {
    const float* mod = (const float*)(P.ws + WS_MOD); const short* SLOT = (const short*)(P.ws + WS_SLOT);
    const int gw = F.vcu * NWAVES + F.wave, NGW = F.G * NWAVES;
    const int rpw = (NT + NGW - 1) / NGW, r0 = gw * rpw, r1 = (r0 + rpw < NT) ? r0 + rpw : NT;
    int slv = -1;
    if (r0 < r1 && F.lane < 16) slv = SLOT[(size_t)F.lane * NT + r0];
    f32x4 gv[4]; int bcur = -1;
    for (int r = r0; r < r1; ++r) {
        const int b = r >> 12, rn = r + 1;
        float* op = P.out + (size_t)r * DM;
        if (b != bcur) { bcur = b;
#pragma unroll
            for (int q = 0; q < 4; ++q) gv[q] = *(const f32x4*)(mod + b * 6144 + 5120 + 512 * (q >> 1) + 8 * F.lane + 4 * (q & 1)) * (1.0f / YS_SCALE); }
        f32x4 xv[4];
#pragma unroll
        for (int q = 0; q < 4; ++q) xv[q] = *(const f32x4*)(op + 512 * (q >> 1) + 8 * F.lane + 4 * (q & 1));
        const int cur = slv;
        if (rn < r1 && F.lane < 16) slv = SLOT[(size_t)F.lane * NT + rn];
        float a[16];
#pragma unroll
        for (int i = 0; i < 16; ++i) a[i] = 0.f;
        for (int e = 0; e < 16; ++e) {
            const int sl = __builtin_amdgcn_readlane(cur, e);
            if (sl >= 0) {
                const u32x2* yp = (const u32x2*)(YS + ((size_t)e * 8192 + b * 512 + sl) * DM);
                const u32x2 y0 = yp[F.lane], y1 = yp[64 + F.lane];
                { const f32x2 p0 = __builtin_amdgcn_cvt_pk_f32_fp8((int)y0.x, false), p1 = __builtin_amdgcn_cvt_pk_f32_fp8((int)y0.x, true), p2 = __builtin_amdgcn_cvt_pk_f32_fp8((int)y0.y, false), p3 = __builtin_amdgcn_cvt_pk_f32_fp8((int)y0.y, true);
                  a[0] += p0[0]; a[1] += p0[1]; a[2] += p1[0]; a[3] += p1[1]; a[4] += p2[0]; a[5] += p2[1]; a[6] += p3[0]; a[7] += p3[1]; }
                { const f32x2 p0 = __builtin_amdgcn_cvt_pk_f32_fp8((int)y1.x, false), p1 = __builtin_amdgcn_cvt_pk_f32_fp8((int)y1.x, true), p2 = __builtin_amdgcn_cvt_pk_f32_fp8((int)y1.y, false), p3 = __builtin_amdgcn_cvt_pk_f32_fp8((int)y1.y, true);
                  a[8] += p0[0]; a[9] += p0[1]; a[10] += p1[0]; a[11] += p1[1]; a[12] += p2[0]; a[13] += p2[1]; a[14] += p3[0]; a[15] += p3[1]; }
            }
        }
#pragma unroll
        for (int q = 0; q < 4; ++q) {
            const int c = 512 * (q >> 1) + 8 * F.lane + 4 * (q & 1);
            f32x4 o; o[0] = xv[q][0] + gv[q][0] * a[4 * q]; o[1] = xv[q][1] + gv[q][1] * a[4 * q + 1]; o[2] = xv[q][2] + gv[q][2] * a[4 * q + 2]; o[3] = xv[q][3] + gv[q][3] * a[4 * q + 3];
            *(f32x4*)(op + c) = o;
        }
    }
}

constexpr int N_PHASES = 12;
struct Args { const void* in[24]; float* out; unsigned char* ws; int ph_lo, ph_hi; };
__global__ void __launch_bounds__(NTHR, 2) fwd(Args args) {
    extern __shared__ __attribute__((aligned(16))) unsigned char lds_raw[];
    Frame F; F.lds = (LAS unsigned char*)lds_raw; F.tid = threadIdx.x; F.lane = F.tid & 63; F.wave = __builtin_amdgcn_readfirstlane(F.tid >> 6);
    F.G = gridDim.x; { const int bx = blockIdx.x; F.vcu = (F.G % 8 == 0) ? (bx % 8) * (F.G / 8) + bx / 8 : bx; }
    Ptrs P;
    P.x = (const float*)args.in[0]; P.c = (const float*)args.in[1]; P.positions = (const int*)args.in[2]; P.w_ada = (const float*)args.in[3]; P.b_ada = (const float*)args.in[4];
    P.norm1_w = (const float*)args.in[5]; P.w_in = (const float*)args.in[6]; P.q_norm_w = (const float*)args.in[7]; P.k_norm_w = (const float*)args.in[8]; P.conv_w = (const float*)args.in[9];
    P.conv_b = (const float*)args.in[10]; P.lru_w_a = (const float*)args.in[11]; P.lru_b_a = (const float*)args.in[12]; P.lru_w_x = (const float*)args.in[13]; P.lru_b_x = (const float*)args.in[14];
    P.lru_lambda = (const float*)args.in[15]; P.w_attn_branch = (const float*)args.in[16]; P.w_lru_branch = (const float*)args.in[17]; P.w_out = (const float*)args.in[18];
    P.norm2_w = (const float*)args.in[19]; P.w_router = (const float*)args.in[20]; P.w_gate = (const float*)args.in[21]; P.w_up = (const float*)args.in[22]; P.w_down = (const float*)args.in[23];
    P.out = args.out; P.ws = args.ws;
    volatile LAS unsigned* MISC = (volatile LAS unsigned*)(F.lds + MISC_OFF);
    if (F.tid < 4) MISC[F.tid] = 0u;
    __syncthreads();
    const int lo = args.ph_lo, hi = args.ph_hi;
    XcdBarrier bar; bar.bar = (unsigned*)(P.ws + WS_CTL); bar.x = 0; bar.st = nullptr;
    if (hi - lo > 1) bar = xcd_barrier_post((unsigned*)(P.ws + WS_CTL), MISC);
#ifndef PHASE_MASK
#define PHASE_MASK 0xfff
#endif
#define IN(k) (((PHASE_MASK >> (k)) & 1) && lo <= (k) && (k) < hi)
#define SEAM(k) do { if (IN(k) && IN((k) + 1)) xcd_barrier(bar); } while (0)
    const int G = F.G, cid = (int)blockIdx.x;

#ifndef REPEAT_PHASE
#define REPEAT_PHASE (-1)
#endif
#define RUN(k, ...) do { if (IN(k)) { { __VA_ARGS__ } if (REPEAT_PHASE == (k)) { if (hi - lo > 1) xcd_barrier(bar); { __VA_ARGS__ } } SEAM(k); } } while (0)
    RUN(0, phase_prologue(F, P););
    RUN(1, phase_h1(F, P););
    RUN(2,
        {   pg8::Gemm g{(const bf16_t*)((unsigned char*)P.out + DO_H18), (const bf16_t*)(P.ws + WS_WIN8), DM / 2, 0, 9, (127 - WIN_SCALE_LOG2) * 0x01010101, nullptr, nullptr, 0}; pg8::StaticOrder S; S.init(NT, 2304, G, cid);
            EpiInProj E{(bf16_t*)(P.ws + WS_QG), (bf16_t*)(P.ws + WS_XR), (const float*)(P.ws + WS_ROPE), P.q_norm_w, P.k_norm_w, 0};
            pg8::gemm_phase<EpiInProj, true, true, true>(F.lds, g, S, E); });
    RUN(3,
        const int xs_ = (F.G % 8 == 0) ? F.vcu / (F.G / 8) : 0; const int xe_ = xs_ < EXPERT_ITEMS_EARLY ? xs_ : EXPERT_ITEMS_EARLY;
        const int nk_ = (ATTN_NITEM + F.G - 1) / F.G, ka_ = (nk_ * xe_) / EXPERT_ITEMS_EARLY;
        convert_expert_items(F, P, 0, xe_);
        phase_attn(F, P, 0, ka_);
        __syncthreads();
        {   pg8::Gemm g{(const bf16_t*)((unsigned char*)P.out + DO_H1), (const bf16_t*)(P.ws + WS_WIN) + (size_t)2304 * DM, DM, 0, 16, 0, nullptr, nullptr, 0}; pg8::StaticOrder S; S.init(NT, 4096, G, cid);
            EpiInProj E{(bf16_t*)(P.ws + WS_QG), (bf16_t*)(P.ws + WS_XR), (const float*)(P.ws + WS_ROPE), P.q_norm_w, P.k_norm_w, 9};
            pg8::gemm_phase<EpiInProj, true, true>(F.lds, g, S, E); }
        convert_expert_items(F, P, xe_, EXPERT_ITEMS_EARLY);
        phase_attn(F, P, ka_, nk_););
    RUN(4, phase_combine(F, P); phase_lru(F, P););
    RUN(5,
        pg8::Gemm g{(const bf16_t*)(P.ws + WS_ATTN), (const bf16_t*)(P.ws + WS_WAB), 256, 0, 4, 0, (const bf16_t*)(P.ws + WS_LRU), (const bf16_t*)(P.ws + WS_WLB), DM}; pg8::StaticOrder S; S.init(NT, DM, G, cid);
        EpiGate<0> E{(bf16_t*)(P.ws + WS_MRG), (const bf16_t*)(P.ws + WS_SGL), nullptr}; MidRatio M{(const bf16_t*)(P.ws + WS_SGA)};
        pg8::gemm_phase<EpiGate<0>, true, true, false, MidRatio>(F.lds, g, S, E, M););
    RUN(6,
        const int xs_ = (F.G % 8 == 0) ? F.vcu / (F.G / 8) : 0; const int pre_ = EXPERT_ITEMS_EARLY + ((EXPERT_ITEMS_ALL - EXPERT_ITEMS_EARLY) * xs_) / 7;
        convert_expert_items(F, P, EXPERT_ITEMS_EARLY, pre_);
        {   pg8::Gemm g{(const bf16_t*)(P.ws + WS_MRG), (const bf16_t*)(P.ws + WS_WOUT), DM, 0, 4, 0, nullptr, nullptr, 0}; pg8::StaticOrder S; S.init(NT, DM, G, cid);
            EpiX1 E{P.x, P.out, (const float*)(P.ws + WS_MOD) + 2048};
            pg8::gemm_phase<EpiX1, true, true>(F.lds, g, S, E); }
        convert_expert_items(F, P, pre_, EXPERT_ITEMS_ALL););
    RUN(7, phase_h2(F, P, (unsigned char*)(P.ws + WS_H2)););
    RUN(8, phase_topk(F, P););
    RUN(9,
        pg8::Gemm g{(const bf16_t*)(P.ws + WS_H2), (const bf16_t*)(P.ws + WS_WGU), DM / 2, 32, 16, (127 - WGU_SCALE_LOG2) * 0x01010101, nullptr, nullptr, 0}; pg8::StaticOrder S; S.init(NE * 8192, 4096, G, cid);
        EpiGU E{(unsigned char*)(P.ws + WS_HE)};
        LAS unsigned short* tab = (LAS unsigned short*)(F.lds + GA_TAB_OFF);
        { const unsigned short* IDX = (const unsigned short*)(P.ws + WS_IDX);
          unsigned short tv_[16];
          _Pragma("unroll") for (int q = 0; q < 16; ++q) { pg8::Unit uu; const int ui = 2 * q + (F.tid >> 8); tv_[q] = 0; if (S.next(ui, uu)) tv_[q] = IDX[(size_t)(uu.pm >> 1) * 512 + (uu.pm & 1) * 256 + (F.tid & 255)]; }
          _Pragma("unroll") for (int q = 0; q < 16; ++q) tab[(2 * q + (F.tid >> 8)) * 256 + (F.tid & 255)] = tv_[q]; }
        __syncthreads();
        pg8::gemm_phase<EpiGU, true, true, true, pg8::NoMid, GatherH2>(F.lds, g, S, E, pg8::NoMid{}, GatherH2{tab}););
    RUN(10,
        pg8::Gemm g{(const bf16_t*)(P.ws + WS_HE), (const bf16_t*)(P.ws + WS_WD), FF / 2, 32, 4, (127 - WD_SCALE_LOG2) * 0x01010101, nullptr, nullptr, 0}; pg8::StaticOrder S; S.init(NE * 8192, DM, G, cid);
        EpiDown E{(unsigned char*)(P.ws + WS_YS), (const float*)(P.ws + WS_GTS)};
        pg8::gemm_phase<EpiDown, true, true, true>(F.lds, g, S, E););
    if (IN(11)) { phase_final(F, P, (const unsigned char*)(P.ws + WS_YS)); }
#undef RUN
#undef IN
#undef SEAM
}

extern "C" void kernel_launch(void* const* d_in, const int* in_sizes, int n_in, void* d_out, int out_size, void* d_ws, size_t ws_size, hipStream_t stream) {
    static int grid = 0;
    if (grid == 0) {
        if (n_in != 24 || in_sizes[0] != NT * DM || out_size != NT * DM || ws_size < (size_t)1024 * MiB) {
            fprintf(stderr, "kernel_launch: unexpected shapes (n_in %d, in0 %d, out %d, ws %zu need %zu); nothing launched\n", n_in, n_in > 0 ? in_sizes[0] : -1, out_size, ws_size, (size_t)1024 * MiB); grid = -1; return; }
        int dev = 0, cus = 0, per_cu = 0;
        if (hipGetDevice(&dev) != hipSuccess || hipDeviceGetAttribute(&cus, hipDeviceAttributeMultiprocessorCount, dev) != hipSuccess) { grid = -1; return; }
        if (hipFuncSetAttribute((const void*)fwd, hipFuncAttributeMaxDynamicSharedMemorySize, LDS_BYTES) != hipSuccess) { fprintf(stderr, "kernel_launch: hipFuncSetAttribute failed\n"); grid = -1; return; }
        if (hipOccupancyMaxActiveBlocksPerMultiprocessor(&per_cu, (const void*)fwd, NTHR, LDS_BYTES) != hipSuccess || per_cu < 1) { fprintf(stderr, "kernel_launch: occupancy query says %d blocks per CU\n", per_cu); }
        (void)hipGetLastError();
        grid = cus;
    }
    if (grid < 0) return;
    (void)hipMemsetAsync((char*)d_ws + WS_CTL, 0, CTL_ZERO_BYTES, stream);
    Args a{};
    for (int i = 0; i < 24; ++i) a.in[i] = d_in[i];
    a.out = (float*)d_out; a.ws = (unsigned char*)d_ws;
#if MK_N_LAUNCHES == 1
    a.ph_lo = 0; a.ph_hi = N_PHASES;
    hipLaunchKernelGGL(fwd, dim3(grid), dim3(NTHR), LDS_BYTES, stream, a);
#else
    for (int p = 0; p < N_PHASES; ++p) { a.ph_lo = p; a.ph_hi = p + 1; hipLaunchKernelGGL(fwd, dim3(grid), dim3(NTHR), LDS_BYTES, stream, a); }
#endif
}
```

```cpp
#include <hip/hip_runtime.h>
#include <cstdio>
#include <cstdint>

#ifndef MK_N_LAUNCHES
#define MK_N_LAUNCHES 1
#endif

#define LAS __attribute__((address_space(3)))
#define GAS __attribute__((address_space(1)))
typedef unsigned short bf16_t;
typedef short bf16x8 __attribute__((ext_vector_type(8)));
typedef short s16x4 __attribute__((ext_vector_type(4)));
typedef short v4i16_t __attribute__((ext_vector_type(4)));
typedef float f32x2 __attribute__((ext_vector_type(2)));
typedef float f32x4 __attribute__((ext_vector_type(4)));
typedef float f32x16 __attribute__((ext_vector_type(16)));
typedef unsigned u32x2 __attribute__((ext_vector_type(2)));
typedef _Float16 h16x2 __attribute__((ext_vector_type(2)));
typedef _Float16 h16x8 __attribute__((ext_vector_type(8)));
typedef unsigned u32x4 __attribute__((ext_vector_type(4)));

constexpr int NB = 16, SEQ = 4096, DM = 1024, NT = NB * SEQ;
constexpr int NIN = 6400, NE = 16, CAP = 512, FF = 2048;
constexpr int NWAVES = 8, NTHR = 512;
constexpr float NORM_EPS = 1e-6f;
constexpr float LOG2E = 1.4426950408889634f, LN2 = 0.6931471805599453f;

constexpr size_t MiB = 1u << 20;
constexpr size_t WS_CTL = 0, CTL_ZERO_BYTES = 64 * 1024;
constexpr size_t WS_MOD = 1 * MiB;
constexpr size_t WS_ROPE = 2 * MiB;
constexpr size_t WS_WIN = 18 * MiB;
constexpr size_t WS_WAB = WS_WIN + (size_t)NIN * DM * 2;
constexpr size_t WS_WLB = WS_WAB + (size_t)DM * 256 * 2;
constexpr size_t WS_WOUT = WS_WLB + (size_t)DM * DM * 2;
constexpr size_t WS_WLRU = WS_WOUT + (size_t)DM * DM * 2;
constexpr size_t WS_AFF = 36 * MiB;
constexpr size_t WS_GTS = 40 * MiB;
constexpr size_t WS_IDX = 40 * MiB + 512 * 1024;
constexpr size_t WS_SLOT = 41 * MiB;
constexpr size_t WS_LSE = 44 * MiB;
constexpr size_t WS_ATTN = 48 * MiB;
constexpr size_t WS_P = 80 * MiB;
constexpr size_t WS_QG = WS_P, WS_KG = WS_QG + 96 * MiB, WS_VG = WS_KG + 96 * MiB;
constexpr size_t WS_XR = WS_VG + 96 * MiB, WS_GY = WS_XR + 128 * MiB, WS_SGA = WS_GY + 128 * MiB, WS_SGL = WS_SGA + 128 * MiB;
constexpr size_t WS_PEND = WS_SGL + 128 * MiB;
constexpr size_t WS_LRU = WS_QG;
constexpr size_t WS_T1 = WS_LRU + 128 * MiB;
constexpr size_t WS_MRG = WS_XR;
constexpr size_t WS_HE = 48 * MiB;
constexpr size_t WS_WD = 880 * MiB;
constexpr size_t WS_WGU = WS_WD + 32 * MiB;
constexpr size_t WS_XE = WS_HE + 352 * MiB;
constexpr size_t WS_H2 = WS_XE + 128 * MiB;
constexpr size_t WS_YS = WS_H2 + 64 * MiB;
constexpr size_t WS_X1B = 752 * MiB;
constexpr size_t WS_END = WS_YS + 256 * MiB;
constexpr int WGU_SCALE_LOG2 = 5, WD_SCALE_LOG2 = 6, WIN_SCALE_LOG2 = 5;
constexpr size_t WS_WIN8 = WS_LSE;
constexpr size_t DO_H18 = 128 * MiB;
static_assert(WS_PEND <= 1024 * MiB && WS_END <= 1024 * MiB, "d_ws map");
constexpr size_t DO_H1 = 0, DO_HF = 0, DO_OG = 128 * MiB;

constexpr int RING_BYTES = 131072;
constexpr int MISC_OFF = 163840 - 256;
constexpr int LDS_BYTES = 163840;

typedef __bf16 bf16x2v __attribute__((ext_vector_type(2)));
__device__ __forceinline__ unsigned cvt_pk_bf16(float lo, float hi) { const bf16x2v v = __builtin_convertvector((f32x2){lo, hi}, bf16x2v); return __builtin_bit_cast(unsigned, v); }
__device__ __forceinline__ float bf2f(unsigned short b) { return __uint_as_float(((unsigned)b) << 16); }
__device__ __forceinline__ float bflo(unsigned w) { return __uint_as_float(w << 16); }
__device__ __forceinline__ float bfhi(unsigned w) { return __uint_as_float(w & 0xffff0000u); }
__device__ __forceinline__ float fast_exp2(float x) { return __builtin_amdgcn_exp2f(x); }
__device__ __forceinline__ float fast_rcp(float x) { return __builtin_amdgcn_rcpf(x); }
__device__ __forceinline__ float sigmoidf_(float x) { return fast_rcp(1.0f + fast_exp2(-x * LOG2E)); }
__device__ __forceinline__ float gelu_tanh(float x) { const float u = 0.7978845608028654f * (x + 0.044715f * x * x * x); return x * fast_rcp(1.0f + fast_exp2(-2.0f * LOG2E * u)); }
template <int CTRL> __device__ __forceinline__ float dppf(float x) { return __builtin_bit_cast(float, __builtin_amdgcn_mov_dpp(__builtin_bit_cast(int, x), CTRL, 0xf, 0xf, true)); }
__device__ __forceinline__ float xrow16_sum(float x) {
    auto s = __builtin_amdgcn_permlane16_swap(__float_as_uint(x), __float_as_uint(x), false, false);
    x = __uint_as_float(s[0]) + __uint_as_float(s[1]);
    auto t = __builtin_amdgcn_permlane32_swap(__float_as_uint(x), __float_as_uint(x), false, false);
    return __uint_as_float(t[0]) + __uint_as_float(t[1]);
}
__device__ __forceinline__ float row16_max(float x) { x = fmaxf(x, dppf<0xB1>(x)); x = fmaxf(x, dppf<0x4E>(x)); x = fmaxf(x, dppf<0x124>(x)); return fmaxf(x, dppf<0x128>(x)); }
__device__ __forceinline__ float row16_sum(float x) { x += dppf<0xB1>(x); x += dppf<0x4E>(x); x += dppf<0x124>(x); return x + dppf<0x128>(x); }
__device__ __forceinline__ float wave_sum(float v) { return xrow16_sum(row16_sum(v)); }
__device__ __forceinline__ unsigned pk4_fp8(float a, float b, float c, float d) { unsigned w = 0u; w = __builtin_amdgcn_cvt_pk_fp8_f32(a, b, w, false); w = __builtin_amdgcn_cvt_pk_fp8_f32(c, d, w, true); return w; }
__device__ __forceinline__ unsigned pkh(float a, float b) { return __builtin_bit_cast(unsigned, __builtin_amdgcn_cvt_pkrtz(a, b)); }
__device__ __forceinline__ u32x4 pack8h(const f32x4 a, const f32x4 b) { u32x4 w; w.x = pkh(a[0], a[1]); w.y = pkh(a[2], a[3]); w.z = pkh(b[0], b[1]); w.w = pkh(b[2], b[3]); return w; }
__device__ __forceinline__ h16x2 ash2(unsigned w) { return __builtin_bit_cast(h16x2, w); }
__device__ __forceinline__ unsigned asu(h16x2 v) { return __builtin_bit_cast(unsigned, v); }
#define LDS_WAIT() asm volatile("s_waitcnt lgkmcnt(0)" ::: "memory")
#define VM_WAIT() asm volatile("s_waitcnt vmcnt(0)" ::: "memory")

namespace pg8 {
constexpr int BM = 256, BK = 64, HALF = 128, HTB = HALF * BK * 2, STAGE_BYTES = 8 * HTB, NXCD = 8, WGM = 8;
__host__ __device__ __forceinline__ int lds_byte(int r, int c) { const int st = (r >> 4) * 2 + (c >> 5), rr = r & 15, cc = c & 31, ob = rr * 64 + cc * 2; return st * 1024 + (ob ^ (((ob >> 9) & 1) << 5)); }
__host__ __device__ __forceinline__ void stage_rc(int b, int& R, int& C) { const int st = b / 1024, sb = b % 1024, swz = sb ^ (((sb >> 9) & 1) << 5); R = (st >> 1) * 16 + swz / 64; C = (st & 1) * 32 + (swz % 64) / 2; }
__host__ __device__ __forceinline__ int perm32(int rho) { const int n = rho >> 4, i = rho & 15; return 8 * (i >> 2) + 4 * n + (i & 3); }

struct Unit { int pm, pn; };
struct Gemm { const bf16_t* A; const bf16_t* Bt; int K; int mgrp; int nN; int wscale; const bf16_t* A2; const bf16_t* Bt2; int K2; };
typedef int v4i_t __attribute__((ext_vector_type(4)));
typedef int v8i_t __attribute__((ext_vector_type(8)));

struct StaticOrder {
    int nM, nN, nwg, G, c;
    __host__ __device__ __forceinline__ void init(int M, int N, int G_, int c_) { nM = M / BM; nN = N / BM; nwg = nM * nN; G = G_; c = c_; }
    __host__ __device__ __forceinline__ bool next(int i, Unit& u) const {
        const long L = (long)i * G + c; if (L >= nwg) return false;
        int wgid = (int)L; { const int q = nwg / NXCD, r = nwg % NXCD, xcd = wgid % NXCD, off = wgid / NXCD; wgid = (xcd < r ? xcd * (q + 1) : r * (q + 1) + (xcd - r) * q) + off; }
        const int nig = WGM * nN, gid = wgid / nig, fm = gid * WGM, gsz = (nM - fm) < WGM ? (nM - fm) : WGM;
        u.pm = fm + ((wgid % nig) % gsz); u.pn = (wgid % nig) / gsz; return true;
    }
};

struct NoMid { static constexpr bool DUAL = false; __device__ __forceinline__ void operator()(f32x4 (&)[2][2][4][2], const Unit&, int, int, int, int) const {} };
struct NoGather { static constexpr bool ON = false; __device__ __forceinline__ unsigned offs(int, const Unit&, int, int) const { return 0u; } };
template <class Epi, bool ALIGN_EPI, bool SP2, bool F8 = false, class Mid = NoMid, class AG = NoGather>
__device__ __forceinline__ void gemm_phase(LAS unsigned char* lds, const Gemm g, const StaticOrder& S, const Epi& E, const Mid& M = Mid(), const AG& GA = AG()) {
    constexpr bool GATHER = AG::ON; static_assert(!(GATHER && Mid::DUAL), "gather + dual not combined");
    constexpr bool DUAL = Mid::DUAL;
    int tid_ = threadIdx.x; asm volatile("" : "+v"(tid_));
    const int tid = tid_, wid = __builtin_amdgcn_readfirstlane(tid >> 6), lane = tid & 63, wr = wid >> 2, wc = wid & 3, fr = lane & 15, fq = lane >> 4;
    const int K0 = g.K, K1 = DUAL ? g.K2 : g.K;
    unsigned vA0[2], vB0[2], vA1[2], vB1[2];
    int Rl[2], Cl[2];
#pragma unroll
    for (int i = 0; i < 2; ++i) { int R, C; stage_rc(tid * 16 + i * 8192, R, C); Rl[i] = R; Cl[i] = C; const int Rb = Epi::PERM ? ((R & ~31) + perm32(R & 31)) : R;
        vA0[i] = (unsigned)(R * K0 + C) * 2u; vB0[i] = (unsigned)(Rb * K0 + C) * 2u; vA1[i] = (unsigned)(R * K1 + C) * 2u; vB1[i] = (unsigned)(Rb * K1 + C) * 2u; }
    const unsigned kstep = (unsigned)(BK * 2);
    const unsigned hstep0 = (unsigned)HALF * K0 * 2u, hstep1 = (unsigned)HALF * K1 * 2u;
    const __amdgpu_buffer_rsrc_t rA0 = __builtin_amdgcn_make_buffer_rsrc((void*)g.A, 0, 0x7fffffff, 0x00020000), rB0 = __builtin_amdgcn_make_buffer_rsrc((void*)g.Bt, 0, 0x7fffffff, 0x00020000);
    const __amdgpu_buffer_rsrc_t rA1 = __builtin_amdgcn_make_buffer_rsrc((void*)(DUAL ? g.A2 : g.A), 0, 0x7fffffff, 0x00020000), rB1 = __builtin_amdgcn_make_buffer_rsrc((void*)(DUAL ? g.Bt2 : g.Bt), 0, 0x7fffffff, 0x00020000);
    __amdgpu_buffer_rsrc_t crA = rA0, crB = rB0;
    const unsigned ldsw = (unsigned)wid * 1024u;
    const int aoff = lds_byte(wr * 64 + fr, fq * 8), boff = lds_byte(wc * 32 + fr, fq * 8);
#define PG8_SA(b, h) (((b) * 2 + (h)) * HTB)
#define PG8_SB(b, h) ((4 + (b) * 2 + (h)) * HTB)
#define PG8_STAGE_R(bufoff, rs, soff, voff) do { _Pragma("unroll") for (int _i = 0; _i < 2; ++_i) \
        __builtin_amdgcn_raw_ptr_buffer_load_lds(rs, (LAS void*)(lds + (bufoff) + ldsw + _i * 8192), 16, (int)(voff)[_i], (int)(soff), 0, 0); } while (0)
#define PG8_STAGE_A(bufoff, soff, voff) PG8_STAGE_R(bufoff, crA, soff, voff)
#define PG8_STAGE_A1(bufoff, rs, soff, hsv, voff0, voff1) do { if constexpr (GATHER) PG8_STAGE_R(bufoff, rs, soff, voff1); else PG8_STAGE_R(bufoff, rs, (soff) + (hsv), voff0); } while (0)
#define PG8_STAGE_B(bufoff, soff, voff) PG8_STAGE_R(bufoff, crB, soff, voff)
#define PG8_LDA(dst, b, h) do { if constexpr (F8) { _Pragma("unroll") for (int m = 0; m < 4; ++m) { const v4i_t lo_ = *(const LAS v4i_t*)(lds + PG8_SA(b, h) + aoff + m * 2048), hi_ = *(const LAS v4i_t*)(lds + PG8_SA(b, h) + aoff + m * 2048 + 1024); \
            dst##8[m] = __builtin_shufflevector(lo_, hi_, 0, 1, 2, 3, 4, 5, 6, 7); } } \
        else { _Pragma("unroll") for (int m = 0; m < 4; ++m) _Pragma("unroll") for (int k = 0; k < 2; ++k) dst[m][k] = *(const LAS bf16x8*)(lds + PG8_SA(b, h) + aoff + m * 2048 + k * 1024); } } while (0)
#define PG8_LDB(dst, b, h) do { if constexpr (F8) { _Pragma("unroll") for (int n = 0; n < 2; ++n) { const v4i_t lo_ = *(const LAS v4i_t*)(lds + PG8_SB(b, h) + boff + n * 2048), hi_ = *(const LAS v4i_t*)(lds + PG8_SB(b, h) + boff + n * 2048 + 1024); \
            dst##8[n] = __builtin_shufflevector(lo_, hi_, 0, 1, 2, 3, 4, 5, 6, 7); } } \
        else { _Pragma("unroll") for (int n = 0; n < 2; ++n) _Pragma("unroll") for (int k = 0; k < 2; ++k) dst[n][k] = *(const LAS bf16x8*)(lds + PG8_SB(b, h) + boff + n * 2048 + k * 1024); } } while (0)
#define PG8_MMA(ai, bj, At, Bt) do { __builtin_amdgcn_s_setprio(1); \
        if constexpr (F8) { _Pragma("unroll") for (int m = 0; m < 4; ++m) _Pragma("unroll") for (int n = 0; n < 2; ++n) \
            asm volatile("v_mfma_scale_f32_16x16x128_f8f6f4 %0, %1, %2, %0, %3, %4 op_sel_hi:[0,0,0]" : "+v"(acc[ai][bj][m][n]) : "v"(Bt##8[n]), "v"(At##8[m]), "v"(wsc_), "v"(one_)); \
        } else { _Pragma("unroll") for (int m = 0; m < 4; ++m) _Pragma("unroll") for (int n = 0; n < 2; ++n) _Pragma("unroll") for (int k = 0; k < 2; ++k) \
            acc[ai][bj][m][n] = __builtin_amdgcn_mfma_f32_16x16x32_bf16(Bt[n][k], At[m][k], acc[ai][bj][m][n], 0, 0, 0); } \
        __builtin_amdgcn_s_setprio(0); } while (0)
#define PG8_MMAZ(ai, bj, At, Bt) do { __builtin_amdgcn_s_setprio(1); \
        if constexpr (F8) { _Pragma("unroll") for (int m = 0; m < 4; ++m) _Pragma("unroll") for (int n = 0; n < 2; ++n) \
            asm volatile("v_mfma_scale_f32_16x16x128_f8f6f4 %0, %1, %2, 0, %3, %4 op_sel_hi:[0,0,0]" : "=&v"(acc[ai][bj][m][n]) : "v"(Bt##8[n]), "v"(At##8[m]), "v"(wsc_), "v"(one_)); \
        } else { _Pragma("unroll") for (int m = 0; m < 4; ++m) _Pragma("unroll") for (int n = 0; n < 2; ++n) { \
            acc[ai][bj][m][n] = __builtin_amdgcn_mfma_f32_16x16x32_bf16(Bt[n][0], At[m][0], (f32x4){0.f, 0.f, 0.f, 0.f}, 0, 0, 0); \
            acc[ai][bj][m][n] = __builtin_amdgcn_mfma_f32_16x16x32_bf16(Bt[n][1], At[m][1], acc[ai][bj][m][n], 0, 0, 0); } } \
        __builtin_amdgcn_s_setprio(0); } while (0)
#define PG8_WAIT_V(n) asm volatile("s_waitcnt vmcnt(" #n ")" ::: "memory")
#define PG8_WAIT_L(n) asm volatile("s_waitcnt lgkmcnt(" #n ")" ::: "memory")
#define PG8_BAR __builtin_amdgcn_s_barrier()
#define PG8_SCHED __builtin_amdgcn_sched_barrier(0)
#define PG8_BTILE(u) ((size_t)((g.mgrp ? ((u).pm / g.mgrp) * g.nN : 0) + (u).pn))
    Unit cur, nxt; int vi = 0, csub = 0, nsub = 0;
    if (!S.next(0, cur)) return;
    constexpr bool ROT = SP2 && !DUAL;
    f32x4 acc[2][2][4][2];
    if constexpr (!ROT) {
#pragma unroll
    for (int a = 0; a < 2; ++a)
#pragma unroll
        for (int b = 0; b < 2; ++b)
#pragma unroll
            for (int m = 0; m < 4; ++m)
#pragma unroll
                for (int n = 0; n < 2; ++n) acc[a][b][m][n] = (f32x4){0.f, 0.f, 0.f, 0.f};
    }
    bf16x8 At[4][2], B0[2][2], B1[2][2]; v8i_t At8[4], B08[2], B18[2];
    const int wsc_ = g.wscale, one_ = 0x7f7f7f7f;
    unsigned cA = (unsigned)cur.pm * 2u * hstep0, cB = (unsigned)PG8_BTILE(cur) * 2u * hstep0;
    unsigned chs = hstep0; unsigned cvA[2] = {vA0[0], vA0[1]}, cvB[2] = {vB0[0], vB0[1]}; int cnt = K0 / BK;
    unsigned cA0[2], cA1[2];
#pragma unroll
    for (int i = 0; i < 2; ++i) { if constexpr (GATHER) { cA0[i] = GA.offs(0, cur, Rl[i], Cl[i]); cA1[i] = GA.offs(0, cur, 128 + Rl[i], Cl[i]); } else { cA0[i] = cvA[i]; cA1[i] = cvA[i] + (unsigned)chs; } }
    if constexpr (GATHER) cA = 0u;
    if constexpr (SP2) {
        PG8_STAGE_B(PG8_SB(0, 0), cB, cvB); PG8_STAGE_B(PG8_SB(0, 1), cB + chs, cvB); PG8_STAGE_A(PG8_SA(0, 0), cA, cA0); PG8_STAGE_A1(PG8_SA(0, 1), crA, cA, chs, cA0, cA1);
        if (wr == 1) PG8_BAR;
        PG8_WAIT_V(2); PG8_BAR;
        PG8_STAGE_B(PG8_SB(1, 0), cB + kstep, cvB); PG8_STAGE_A(PG8_SA(1, 0), cA + kstep, cA0); PG8_STAGE_B(PG8_SB(1, 1), cB + chs + kstep, cvB);
        PG8_WAIT_V(6); PG8_BAR;
    } else {
        PG8_STAGE_B(PG8_SB(0, 0), cB, cvB); PG8_STAGE_A(PG8_SA(0, 0), cA, cA0); PG8_STAGE_B(PG8_SB(0, 1), cB + chs, cvB); PG8_STAGE_A1(PG8_SA(0, 1), crA, cA, chs, cA0, cA1);
        if (wr == 1) PG8_BAR;
        PG8_WAIT_V(4); PG8_BAR;
        PG8_STAGE_B(PG8_SB(1, 0), cB + kstep, cvB); PG8_STAGE_A(PG8_SA(1, 0), cA + kstep, cA0); PG8_STAGE_B(PG8_SB(1, 1), cB + chs + kstep, cvB);
        PG8_WAIT_V(6); PG8_BAR;
    }
#define PG8_TRIP_LOCALS \
            const bool last = (t == cnt - 2); \
            const unsigned a1 = cA + (unsigned)(t + 1) * kstep; \
            const unsigned a2 = last ? nA : cA + (unsigned)(t + 2) * kstep, b2 = last ? nB : cB + (unsigned)(t + 2) * kstep; \
            const unsigned a3 = a2 + kstep, b3 = b2 + kstep; \
            const unsigned hs2 = (DUAL && last) ? nhs : chs; \
            unsigned wA[2], wB[2]; \
            _Pragma("unroll") for (int i = 0; i < 2; ++i) { wA[i] = ((DUAL || GATHER) && last) ? nA0[i] : cA0[i]; wB[i] = (DUAL && last) ? nvB[i] : cvB[i]; } \
            unsigned wA1[2]; \
            _Pragma("unroll") for (int i = 0; i < 2; ++i) wA1[i] = ((DUAL || GATHER) && last) ? nA1[i] : cA1[i]; \
            __amdgpu_buffer_rsrc_t wrA = crA, wrB = crB; \
            if (DUAL && last && has_next) { wrA = nsub ? rA1 : rA0; wrB = nsub ? rB1 : rB0; }
#define PG8_TRIP0_LOCALS \
        const unsigned a1 = cA + kstep, a2 = cA + 2u * kstep, b2 = cB + 2u * kstep, a3 = a2 + kstep, b3 = b2 + kstep, hs2 = chs; \
        const unsigned (&wA)[2] = cA0; const unsigned (&wB)[2] = cvB; const unsigned (&wA1)[2] = cA1; \
        const __amdgpu_buffer_rsrc_t wrA = crA, wrB = crB;
#define PG8_TRIP_SP2(MM) \
            PG8_LDB(B0, 0, 0); PG8_LDB(B1, 0, 1); PG8_SCHED; PG8_LDA(At, 0, 0); PG8_STAGE_A1(PG8_SA(1, 1), crA, a1, chs, cA0, cA1); \
            PG8_WAIT_V(8); PG8_WAIT_L(0); PG8_BAR; MM(0, 0, At, B0); MM(0, 1, At, B1); PG8_BAR; PG8_SCHED; \
            PG8_LDA(At, 0, 1); PG8_STAGE_R(PG8_SB(0, 0), wrB, b2, wB); PG8_STAGE_R(PG8_SB(0, 1), wrB, b2 + hs2, wB); PG8_STAGE_R(PG8_SA(0, 0), wrA, a2, wA); \
            PG8_WAIT_V(8); PG8_WAIT_L(0); PG8_BAR; MM(1, 0, At, B0); MM(1, 1, At, B1); PG8_BAR; PG8_SCHED; \
            PG8_LDB(B0, 1, 0); PG8_LDB(B1, 1, 1); PG8_SCHED; PG8_LDA(At, 1, 0); PG8_STAGE_A1(PG8_SA(0, 1), wrA, a2, hs2, wA, wA1); \
            PG8_WAIT_V(8); PG8_WAIT_L(0); PG8_BAR; PG8_MMA(0, 0, At, B0); PG8_MMA(0, 1, At, B1); PG8_BAR; PG8_SCHED; \
            PG8_LDA(At, 1, 1); PG8_STAGE_R(PG8_SB(1, 0), wrB, b3, wB); PG8_STAGE_R(PG8_SB(1, 1), wrB, b3 + hs2, wB); PG8_STAGE_R(PG8_SA(1, 0), wrA, a3, wA); \
            PG8_WAIT_V(8); PG8_WAIT_L(0); PG8_BAR; PG8_MMA(1, 0, At, B0); PG8_MMA(1, 1, At, B1); PG8_BAR; PG8_SCHED;
    if constexpr (ROT) { PG8_TRIP0_LOCALS PG8_TRIP_SP2(PG8_MMAZ) }
    for (;;) {
        bool has_next;
        if (DUAL && csub == 0) { nxt = cur; nsub = 1; has_next = true; } else { nsub = 0; has_next = S.next((DUAL ? (vi >> 1) : vi) + 1, nxt); }
        const unsigned nhs = has_next ? (nsub ? hstep1 : hstep0) : chs;
        unsigned nvA[2], nvB[2];
#pragma unroll
        for (int i = 0; i < 2; ++i) { nvA[i] = has_next ? (nsub ? vA1[i] : vA0[i]) : cvA[i]; nvB[i] = has_next ? (nsub ? vB1[i] : vB0[i]) : cvB[i]; }
        unsigned nA0[2], nA1[2];
#pragma unroll
        for (int i = 0; i < 2; ++i) { if constexpr (GATHER) { nA0[i] = has_next ? GA.offs(vi + 1, nxt, Rl[i], Cl[i]) : cA0[i]; nA1[i] = has_next ? GA.offs(vi + 1, nxt, 128 + Rl[i], Cl[i]) : cA1[i]; } else { nA0[i] = nvA[i]; nA1[i] = nvA[i] + (unsigned)nhs; } }
        const unsigned nA = GATHER ? 0u : (has_next ? (unsigned)nxt.pm * 2u * nhs : cA), nB = has_next ? (unsigned)PG8_BTILE(nxt) * 2u * nhs : cB;
#pragma nounroll
        for (int t = ROT ? 2 : 0; t < cnt; t += 2) {
            PG8_TRIP_LOCALS
            if constexpr (SP2) {
            PG8_TRIP_SP2(PG8_MMA)
            } else {
            PG8_LDB(B0, 0, 0); PG8_SCHED; PG8_LDA(At, 0, 0); PG8_STAGE_A1(PG8_SA(1, 1), crA, a1, chs, cA0, cA1);
            PG8_WAIT_L(8); PG8_BAR; PG8_WAIT_L(0); PG8_MMA(0, 0, At, B0); PG8_BAR; PG8_SCHED;
            PG8_LDB(B1, 0, 1); PG8_STAGE_R(PG8_SB(0, 0), wrB, b2, wB);
            PG8_BAR; PG8_WAIT_L(0); PG8_MMA(0, 1, At, B1); PG8_BAR;
            PG8_LDA(At, 0, 1); PG8_STAGE_R(PG8_SA(0, 0), wrA, a2, wA);
            PG8_BAR; PG8_WAIT_L(0); PG8_MMA(1, 0, At, B0); PG8_BAR; PG8_SCHED;
            PG8_STAGE_R(PG8_SB(0, 1), wrB, b2 + hs2, wB);
            PG8_WAIT_V(6); PG8_BAR; PG8_MMA(1, 1, At, B1); PG8_BAR;
            PG8_LDB(B0, 1, 0); PG8_SCHED; PG8_LDA(At, 1, 0); PG8_STAGE_A1(PG8_SA(0, 1), wrA, a2, hs2, wA, wA1);
            PG8_WAIT_L(8); PG8_BAR; PG8_WAIT_L(0); PG8_MMA(0, 0, At, B0); PG8_BAR; PG8_SCHED;
            PG8_LDB(B1, 1, 1); PG8_STAGE_R(PG8_SB(1, 0), wrB, b3, wB);
            PG8_BAR; PG8_WAIT_L(0); PG8_MMA(0, 1, At, B1); PG8_BAR;
            PG8_LDA(At, 1, 1); PG8_STAGE_R(PG8_SA(1, 0), wrA, a3, wA);
            PG8_BAR; PG8_WAIT_L(0); PG8_MMA(1, 0, At, B0); PG8_BAR; PG8_SCHED;
            PG8_STAGE_R(PG8_SB(1, 1), wrB, b3 + hs2, wB);
            PG8_WAIT_V(6); PG8_BAR; PG8_MMA(1, 1, At, B1); PG8_BAR;
            }
        }
        if constexpr (ALIGN_EPI) { if (wr == 0) PG8_BAR; }
        if constexpr (F8) asm volatile("s_nop 15\n\ts_nop 7" ::: "memory");
        if (DUAL && csub == 0) M(acc, cur, wr, wc, fr, fq);
        else {
            E(acc, cur, wr, wc, fr, fq);
            if (!has_next) break;
            if constexpr (!ROT) {
#pragma unroll
            for (int a = 0; a < 2; ++a)
#pragma unroll
                for (int b = 0; b < 2; ++b)
#pragma unroll
                    for (int m = 0; m < 4; ++m)
#pragma unroll
                        for (int n = 0; n < 2; ++n) acc[a][b][m][n] = (f32x4){0.f, 0.f, 0.f, 0.f};
            }
        }
        cur = nxt; csub = nsub; cA = nA; cB = nB; chs = nhs; cnt = (csub ? K1 : K0) / BK; ++vi;
        if constexpr (DUAL) { crA = csub ? rA1 : rA0; crB = csub ? rB1 : rB0; }
#pragma unroll
        for (int i = 0; i < 2; ++i) { cvA[i] = nvA[i]; cvB[i] = nvB[i]; cA0[i] = nA0[i]; cA1[i] = nA1[i]; }
        if constexpr (ALIGN_EPI) { if (wr == 1) PG8_BAR; }
        if constexpr (ROT) { PG8_TRIP0_LOCALS PG8_TRIP_SP2(PG8_MMAZ) }
    }
    PG8_WAIT_V(0);
    if constexpr (!ALIGN_EPI) { if (wr == 0) PG8_BAR; }
    PG8_BAR;
#undef PG8_SA
#undef PG8_SB
#undef PG8_STAGE_R
#undef PG8_STAGE_A
#undef PG8_STAGE_A1
#undef PG8_STAGE_B
#undef PG8_LDA
#undef PG8_LDB
#undef PG8_MMA
#undef PG8_MMAZ
#undef PG8_TRIP_LOCALS
#undef PG8_TRIP0_LOCALS
#undef PG8_TRIP_SP2
#undef PG8_WAIT_V
#undef PG8_WAIT_L
#undef PG8_BAR
#undef PG8_SCHED
#undef PG8_BTILE
}
}
using pg8::Unit;

__device__ __forceinline__ int perm_row(int r, int sh) {
    const int b = r >> 12, t = r & 4095;
    return (b << 12) + ((t & ((1 << sh) - 1)) << (12 - sh)) + (t >> sh);
}
__device__ __forceinline__ u32x4 pack8(const f32x4 a, const f32x4 b) { u32x4 w; w.x = cvt_pk_bf16(a[0], a[1]); w.y = cvt_pk_bf16(a[2], a[3]); w.z = cvt_pk_bf16(b[0], b[1]); w.w = cvt_pk_bf16(b[2], b[3]); return w; }

struct EpiInProj {
    static constexpr bool PERM = true;
    bf16_t *QKV, *XR4; const float* cs; const float *qnw, *knw; int pn0;
    __device__ __forceinline__ void operator()(const f32x4 (&acc)[2][2][4][2], const Unit& u, int wr, int wc, int fr, int fq) const {
        const int pn = u.pn + pn0; const int row0 = u.pm * 256 + wr * 64 + fr;
        if (pn < 6) {
            const bool isq = pn < 3; const int g = isq ? pn : pn - 3; const int head = 4 * g + wc;
            const float* nw = (isq ? qnw : knw) + head * 64 + 8 * fq;
            const f32x4 wl0 = *(const f32x4*)(nw), wl1 = *(const f32x4*)(nw + 4), wh0 = *(const f32x4*)(nw + 32), wh1 = *(const f32x4*)(nw + 36);
            const float osc = isq ? 0.125f * LOG2E : 1.0f;
            bf16_t* dst = QKV + (size_t)pn * NT * 256;
            const int sh = 2 * g;
            f32x4 csv[2][2][4];
#define QK_LOAD(gi, buf) do { _Pragma("unroll") for (int mm = 0; mm < 2; ++mm) { const float* cr = cs + (size_t)(row0 + ((gi) >> 1) * 128 + (2 * ((gi) & 1) + mm) * 16) * 64 + 8 * fq; \
                csv[buf][mm][0] = *(const f32x4*)(cr); csv[buf][mm][1] = *(const f32x4*)(cr + 4); csv[buf][mm][2] = *(const f32x4*)(cr + 32); csv[buf][mm][3] = *(const f32x4*)(cr + 36); } } while (0)
            QK_LOAD(0, 0);
#pragma unroll
            for (int gi = 0; gi < 4; ++gi) {
                const int ai = gi >> 1, mb = 2 * (gi & 1), buf = gi & 1;
                u32x4 ol[2], oh[2];
#pragma unroll
                for (int mm = 0; mm < 2; ++mm) {
                    const int m = mb + mm;
                    const f32x4 v00 = acc[ai][0][m][0], v01 = acc[ai][0][m][1], v10 = acc[ai][1][m][0], v11 = acc[ai][1][m][1];
                    float ss = 0.f;
#pragma unroll
                    for (int j = 0; j < 4; ++j) ss += v00[j] * v00[j] + v01[j] * v01[j] + v10[j] * v10[j] + v11[j] * v11[j];
                    ss = xrow16_sum(ss);
                    const float rs = __builtin_amdgcn_rsqf(ss * (1.0f / 64.0f) + NORM_EPS);
                    const f32x4 c0 = csv[buf][mm][0], c1 = csv[buf][mm][1], s0 = csv[buf][mm][2], s1 = csv[buf][mm][3];
                    const f32x4 lo0 = v00 * rs * wl0, lo1 = v01 * rs * wl1, hi0 = v10 * rs * wh0, hi1 = v11 * rs * wh1;
                    const f32x4 L0 = (lo0 * c0 - hi0 * s0) * osc, L1 = (lo1 * c1 - hi1 * s1) * osc, H0 = (hi0 * c0 + lo0 * s0) * osc, H1 = (hi1 * c1 + lo1 * s1) * osc;
                    if (isq) { ol[mm] = pack8(L0, L1); oh[mm] = pack8(H0, H1); }
                    else { ol[mm].x = pk4_fp8(L0[0], L0[1], L0[2], L0[3]); ol[mm].y = pk4_fp8(L1[0], L1[1], L1[2], L1[3]); oh[mm].x = pk4_fp8(H0[0], H0[1], H0[2], H0[3]); oh[mm].y = pk4_fp8(H1[0], H1[1], H1[2], H1[3]); }
                }
                if (gi < 3) QK_LOAD(gi + 1, buf ^ 1);
#pragma unroll
                for (int mm = 0; mm < 2; ++mm) { const size_t rp = (size_t)perm_row(row0 + ai * 128 + (mb + mm) * 16, sh);
                    if (isq) { bf16_t* p = dst + rp * 256 + wc * 64 + 8 * fq; *(u32x4*)(p) = ol[mm]; *(u32x4*)(p + 32) = oh[mm]; }
                    else { unsigned char* p = (unsigned char*)(QKV + (size_t)3 * NT * 256) + (size_t)g * NT * 256 + rp * 256 + wc * 64 + 8 * fq;     *(u32x2*)(p) = (u32x2){ol[mm].x, ol[mm].y}; *(u32x2*)(p + 32) = (u32x2){oh[mm].x, oh[mm].y}; } }
            }
#undef QK_LOAD
        } else if (pn < 9) {
            const int g = pn - 6; bf16_t* dst = QKV + (size_t)pn * NT * 256; const int sh = 2 * g;
#pragma unroll
            for (int ai = 0; ai < 2; ++ai)
#pragma unroll
                for (int m = 0; m < 4; ++m) {
                    const int r = row0 + ai * 128 + m * 16; unsigned char* p = (unsigned char*)(QKV + (size_t)6 * NT * 256) + (size_t)g * NT * 256 + (size_t)perm_row(r, sh) * 256 + wc * 32 + 8 * fq;
#pragma unroll
                    for (int bj = 0; bj < 2; ++bj) { const f32x4 a = acc[ai][bj][m][0], b = acc[ai][bj][m][1]; *(u32x2*)(p + bj * 128) = (u32x2){pk4_fp8(a[0], a[1], a[2], a[3]), pk4_fp8(b[0], b[1], b[2], b[3])}; }
                }
        } else if (pn >= 17) {
            bf16_t* RT = XR4 + (size_t)2 * NT * 1024; bf16_t* SL = XR4 + (size_t)3 * NT * 1024; const int col0 = (pn - 17) * 128 + wc * 32 + 8 * fq;
#pragma unroll
            for (int ai = 0; ai < 2; ++ai)
#pragma unroll
                for (int m = 0; m < 4; ++m) {
                    const size_t off = (size_t)(row0 + ai * 128 + m * 16) * 1024 + col0;
                    f32x4 rt[2], sl[2];
#pragma unroll
                    for (int n = 0; n < 2; ++n)
#pragma unroll
                        for (int j = 0; j < 4; ++j) { const float ea = fast_exp2(-LOG2E * acc[ai][0][m][n][j]), el = fast_exp2(-LOG2E * acc[ai][1][m][n][j]);
                            sl[n][j] = fast_rcp(1.0f + el); rt[n][j] = (1.0f + el) * fast_rcp(1.0f + ea); }
                    *(u32x4*)(RT + off) = pack8(rt[0], rt[1]); *(u32x4*)(SL + off) = pack8(sl[0], sl[1]);
                }
        } else {
            const int kind = (pn - 9) >> 2, colbase = ((pn - 9) & 3) * 256;
            bf16_t* dst = XR4 + (size_t)kind * NT * 1024;
#pragma unroll
            for (int ai = 0; ai < 2; ++ai)
#pragma unroll
                for (int m = 0; m < 4; ++m) {
                    const int r = row0 + ai * 128 + m * 16; bf16_t* p = dst + (size_t)r * 1024 + colbase + wc * 32 + 8 * fq;
#pragma unroll
                    for (int bj = 0; bj < 2; ++bj) {
                        f32x4 a = acc[ai][bj][m][0], b = acc[ai][bj][m][1];
                        if (kind == 1) {
#pragma unroll
                            for (int j = 0; j < 4; ++j) { a[j] = gelu_tanh(a[j]); b[j] = gelu_tanh(b[j]); }
                        } else if (kind >= 2) {
#pragma unroll
                            for (int j = 0; j < 4; ++j) { a[j] = sigmoidf_(a[j]); b[j] = sigmoidf_(b[j]); }
                        }
                        *(u32x4*)(p + bj * 128) = pack8h(a, b);
                    }
                }
        }
    }
};
__device__ __forceinline__ void unpack8(const u32x4 w, f32x4& a, f32x4& b) { a = (f32x4){bflo(w.x), bfhi(w.x), bflo(w.y), bfhi(w.y)}; b = (f32x4){bflo(w.z), bfhi(w.z), bflo(w.w), bfhi(w.w)}; }
template <int MODE> struct EpiGate {
    static constexpr bool PERM = true;
    bf16_t* O; const bf16_t* G1; const bf16_t* ADD;
    __device__ __forceinline__ void operator()(const f32x4 (&acc)[2][2][4][2], const Unit& u, int wr, int wc, int fr, int fq) const {
        const int row0 = u.pm * 256 + wr * 64 + fr, col0 = u.pn * 256 + wc * 32 + 8 * fq;
        u32x4 g[2][2][2], t[2][2][2];
#define EG_LOAD(gi, buf) do { _Pragma("unroll") for (int mm = 0; mm < 2; ++mm) _Pragma("unroll") for (int bj = 0; bj < 2; ++bj) { \
            const size_t off = (size_t)(row0 + ((gi) >> 1) * 128 + (2 * ((gi) & 1) + mm) * 16) * 1024 + col0 + bj * 128; g[buf][mm][bj] = *(const u32x4*)(G1 + off); if (MODE == 1) t[buf][mm][bj] = *(const u32x4*)(ADD + off); } } while (0)
        EG_LOAD(0, 0);
#pragma unroll
        for (int gi = 0; gi < 4; ++gi) {
            const int ai = gi >> 1, mb = 2 * (gi & 1), buf = gi & 1;
            u32x4 o[2][2];
#pragma unroll
            for (int mm = 0; mm < 2; ++mm)
#pragma unroll
                for (int bj = 0; bj < 2; ++bj) {
                    f32x4 ga, gb; unpack8(g[buf][mm][bj], ga, gb);
                    f32x4 x = acc[ai][bj][mb + mm][0] * ga, y = acc[ai][bj][mb + mm][1] * gb;
                    if (MODE == 1) { f32x4 ta, tb; unpack8(t[buf][mm][bj], ta, tb); x += ta; y += tb; }
                    o[mm][bj] = pack8(x, y);
                }
            if (gi < 3) EG_LOAD(gi + 1, buf ^ 1);
#pragma unroll
            for (int mm = 0; mm < 2; ++mm)
#pragma unroll
                for (int bj = 0; bj < 2; ++bj) *(u32x4*)(O + (size_t)(row0 + ai * 128 + (mb + mm) * 16) * 1024 + col0 + bj * 128) = o[mm][bj];
        }
#undef EG_LOAD
    }
};
constexpr int GA_TAB_OFF = 131072;
struct GatherH2 {
    static constexpr bool ON = true;
    LAS unsigned short* tab;
    __device__ __forceinline__ unsigned offs(int ui, const Unit& u, int R, int C) const {
        const unsigned tok = tab[ui * 256 + R]; const unsigned b = ((unsigned)u.pm & 31u) >> 1;
        return ((b << 12) + tok) * 1024u + (unsigned)C * 2u;
    }
};
struct MidRatio {
    static constexpr bool DUAL = true;
    const bf16_t* RT;
    __device__ __forceinline__ void operator()(f32x4 (&acc)[2][2][4][2], const Unit& u, int wr, int wc, int fr, int fq) const {
        const int row0 = u.pm * 256 + wr * 64 + fr, col0 = u.pn * 256 + wc * 32 + 8 * fq;
        u32x4 ga[2][2][2];
#define MR_LOAD(gi, buf) do { _Pragma("unroll") for (int mm = 0; mm < 2; ++mm) _Pragma("unroll") for (int bj = 0; bj < 2; ++bj) \
            ga[buf][mm][bj] = *(const u32x4*)(RT + (size_t)(row0 + ((gi) >> 1) * 128 + (2 * ((gi) & 1) + mm) * 16) * 1024 + col0 + bj * 128); } while (0)
        MR_LOAD(0, 0);
#pragma unroll
        for (int gi = 0; gi < 4; ++gi) {
            const int ai = gi >> 1, mb = 2 * (gi & 1), buf = gi & 1;
            if (gi < 3) MR_LOAD(gi + 1, buf ^ 1);
#pragma unroll
            for (int mm = 0; mm < 2; ++mm)
#pragma unroll
                for (int bj = 0; bj < 2; ++bj) { f32x4 a0, a1; unpack8(ga[buf][mm][bj], a0, a1); acc[ai][bj][mb + mm][0] *= a0; acc[ai][bj][mb + mm][1] *= a1; }
        }
#undef MR_LOAD
    }
};
struct EpiX1 {
    static constexpr bool PERM = true;
    const float* x; bf16_t* X1; const float* gate;
    __device__ __forceinline__ void operator()(const f32x4 (&acc)[2][2][4][2], const Unit& u, int wr, int wc, int fr, int fq) const {
        const int row0 = u.pm * 256 + wr * 64 + fr, col0 = u.pn * 256 + wc * 32 + 8 * fq;
        const float* gp = gate + (size_t)(u.pm >> 4) * 6144 + col0;
        f32x4 gv[2][2];
#pragma unroll
        for (int bj = 0; bj < 2; ++bj)
#pragma unroll
            for (int n = 0; n < 2; ++n) gv[bj][n] = *(const f32x4*)(gp + bj * 128 + n * 4);
        f32x4 xv[2][4][2][2];
#pragma unroll
        for (int m = 0; m < 4; ++m)
#pragma unroll
            for (int bj = 0; bj < 2; ++bj)
#pragma unroll
                for (int n = 0; n < 2; ++n) xv[0][m][bj][n] = *(const f32x4*)(x + (size_t)(row0 + m * 16) * 1024 + col0 + bj * 128 + n * 4);
#pragma unroll
        for (int ai = 0; ai < 2; ++ai) {
#pragma unroll
            for (int m = 0; m < 4; ++m)
#pragma unroll
                for (int bj = 0; bj < 2; ++bj)
#pragma unroll
                    for (int n = 0; n < 2; ++n) xv[ai][m][bj][n] += gv[bj][n] * acc[ai][bj][m][n];
            if (ai == 0) {
#pragma unroll
                for (int m = 0; m < 4; ++m)
#pragma unroll
                    for (int bj = 0; bj < 2; ++bj)
#pragma unroll
                        for (int n = 0; n < 2; ++n) xv[1][m][bj][n] = *(const f32x4*)(x + (size_t)(row0 + 128 + m * 16) * 1024 + col0 + bj * 128 + n * 4);
            }
#pragma unroll
            for (int m = 0; m < 4; ++m)
#pragma unroll
                for (int bj = 0; bj < 2; ++bj) *(u32x4*)(X1 + (size_t)(row0 + ai * 128 + m * 16) * 1024 + col0 + bj * 128) = pack8(xv[ai][m][bj][0], xv[ai][m][bj][1]);
        }
    }
};
struct EpiGU {
    static constexpr bool PERM = true;
    unsigned char* HE;
    __device__ __forceinline__ void operator()(const f32x4 (&acc)[2][2][4][2], const Unit& u, int wr, int wc, int fr, int fq) const {
        const int row0 = u.pm * 256 + wr * 64 + fr, col0 = u.pn * 128 + wc * 32 + 8 * fq;
#pragma unroll
        for (int ai = 0; ai < 2; ++ai)
#pragma unroll
            for (int m = 0; m < 4; ++m) {
                f32x4 o[2];
#pragma unroll
                for (int n = 0; n < 2; ++n)
#pragma unroll
                    for (int j = 0; j < 4; ++j) { const float gt = acc[ai][0][m][n][j];
                        o[n][j] = __builtin_amdgcn_fmed3f(gt * acc[ai][1][m][n][j] * fast_rcp(1.0f + fast_exp2(gt)), -448.f, 448.f); }
                u32x2 w; w.x = pk4_fp8(o[0][0], o[0][1], o[0][2], o[0][3]); w.y = pk4_fp8(o[1][0], o[1][1], o[1][2], o[1][3]);
                *(u32x2*)(HE + (size_t)(row0 + ai * 128 + m * 16) * FF + col0) = w;
            }
    }
};
constexpr float YS_SCALE = 16.0f;
struct EpiDown {
    static constexpr bool PERM = true;
    unsigned char* YS; const float* gts;
    __device__ __forceinline__ void operator()(const f32x4 (&acc)[2][2][4][2], const Unit& u, int wr, int wc, int fr, int fq) const {
        const int row0 = u.pm * 256 + wr * 64 + fr, col0 = u.pn * 256 + wc * 32 + 8 * fq;
        float gt[2][4];
#pragma unroll
        for (int ai = 0; ai < 2; ++ai)
#pragma unroll
            for (int m = 0; m < 4; ++m) gt[ai][m] = gts[row0 + ai * 128 + m * 16] * YS_SCALE;
#pragma unroll
        for (int ai = 0; ai < 2; ++ai)
#pragma unroll
            for (int m = 0; m < 4; ++m) {
                const int r = row0 + ai * 128 + m * 16;
#pragma unroll
                for (int bj = 0; bj < 2; ++bj) { const f32x4 a = acc[ai][bj][m][0] * gt[ai][m], b = acc[ai][bj][m][1] * gt[ai][m];
                    u32x2 w; w.x = pk4_fp8(a[0], a[1], a[2], a[3]); w.y = pk4_fp8(b[0], b[1], b[2], b[3]);
                    *(u32x2*)(YS + (size_t)r * 1024 + col0 + bj * 128) = w; }
            }
    }
};
#define XB_TMO      128
#define XB_XCNT(j)  (256  + 64 * (j))
#define XB_XSUB(j)  (1280 + 64 * (j))
#define XB_XGEN(j)  (2304 + 64 * (j))
#define XB_TOP      3328
#define XB_TOPGEN   3392
#define XCD_BAR_WORDS 3456
#define XB_SPIN_CAP (1u << 18)
__device__ __forceinline__ unsigned xb_ld(unsigned* p)              { return __hip_atomic_load(p, __ATOMIC_RELAXED, __HIP_MEMORY_SCOPE_AGENT); }
__device__ __forceinline__ unsigned xb_add(unsigned* p, unsigned v) { return __hip_atomic_fetch_add(p, v, __ATOMIC_RELAXED, __HIP_MEMORY_SCOPE_AGENT); }
__device__ __forceinline__ unsigned xb_xcc_id() { return (unsigned)__builtin_amdgcn_s_getreg((3 << 11) | 20) & 0xFu; }
#define XB_SPIN(cond, bar) do { unsigned _sp = 0; while (cond) { __builtin_amdgcn_s_sleep(1); \
    if ((++_sp & 255u) == 0u) { if (xb_ld(&(bar)[XB_TMO])) break; if (_sp > XB_SPIN_CAP) { atomicAdd(&(bar)[XB_TMO], 1u); break; } } } } while (0)
struct XcdBarrier { unsigned* bar; unsigned x; volatile LAS unsigned* st; };
__device__ __forceinline__ XcdBarrier xcd_barrier_post(unsigned* bar, volatile LAS unsigned* st) {
    XcdBarrier b; b.bar = bar; b.x = xb_xcc_id(); b.st = st;
    if (threadIdx.x == 0) (void)xb_add(&bar[XB_XCNT(b.x)], 1u);
    return b;
}
__device__ __forceinline__ void xcd_barrier_complete(unsigned* bar, unsigned x, unsigned& nloc, unsigned& nx) {
    const unsigned G = gridDim.x * gridDim.y * gridDim.z;
    unsigned sum, cnt, mine, sp = 0u;
    for (;;) {
        sum = 0u; cnt = 0u; mine = 0u;
#pragma unroll
        for (unsigned j = 0; j < 16; ++j) { const unsigned c = xb_ld(&bar[XB_XCNT(j)]); sum += c; cnt += (c > 0u) ? 1u : 0u; mine = (j == x) ? c : mine; }
        if (sum == G) break;
        __builtin_amdgcn_s_sleep(1);
        if ((++sp & 255u) == 0u) { if (xb_ld(&bar[XB_TMO])) break; if (sp > XB_SPIN_CAP) { atomicAdd(&bar[XB_TMO], 1u); break; } }
    }
    nloc = mine > 0u ? mine : 1u; nx = cnt > 0u ? cnt : 1u;
}
__device__ __forceinline__ void xcd_barrier(const XcdBarrier& b) {
    asm volatile("s_waitcnt vmcnt(0)" ::: "memory");
    __syncthreads();
    if (threadIdx.x == 0) {
        unsigned* bar = b.bar;
        __builtin_amdgcn_s_waitcnt(0);
        unsigned nloc = b.st[0], nx = b.st[1];
        if (nloc == 0u) { xcd_barrier_complete(bar, b.x, nloc, nx); b.st[0] = nloc; b.st[1] = nx; }
        const unsigned old = xb_add(&bar[XB_XSUB(b.x)], 1u);
        const unsigned gen = old / nloc;
        if (old + 1u == (gen + 1u) * nloc) {
            __builtin_amdgcn_fence(__ATOMIC_RELEASE, "agent");
            asm volatile("s_waitcnt vmcnt(0)" ::: "memory");
            const unsigned og = xb_add(&bar[XB_TOP], 1u);
            const unsigned tg = og / nx;
            if (og + 1u == (tg + 1u) * nx) xb_add(&bar[XB_TOPGEN], 1u);
            else XB_SPIN(xb_ld(&bar[XB_TOPGEN]) == tg, bar);
            __builtin_amdgcn_fence(__ATOMIC_ACQUIRE, "agent");
            xb_add(&bar[XB_XGEN(b.x)], 1u);
            asm volatile("s_waitcnt vmcnt(0)" ::: "memory");
        } else {
            XB_SPIN(xb_ld(&bar[XB_XGEN(b.x)]) == gen, bar);
            __builtin_amdgcn_fence(__ATOMIC_ACQUIRE, "agent");
            asm volatile("s_waitcnt vmcnt(0)" ::: "memory");
        }
    }
    __syncthreads();
}

struct Frame { LAS unsigned char* lds; int tid, lane, wave, vcu, G; };

template <class RowMap>
__device__ __forceinline__ void transpose_item(const float* W, int K, int N, bf16_t* WT, const RowMap& rm, LAS float* scr, int item, int lane, float scale = 1.0f, bool f16out = false) {
    const int nblk = N / 32, kb = item / nblk, nb = item % nblk, k0 = 64 * kb, n0 = 32 * nb;
    float tv_[32];
#pragma unroll
    for (int i = 0; i < 32; ++i) tv_[i] = W[(size_t)(k0 + 2 * i + (lane >> 5)) * N + n0 + (lane & 31)];
#pragma unroll
    for (int i = 0; i < 32; ++i) scr[(2 * i + (lane >> 5)) * 33 + (lane & 31)] = tv_[i];
    LDS_WAIT();
    const int c = lane & 7;
#pragma unroll
    for (int j = 0; j < 4; ++j) { const int n = (lane >> 3) + 8 * j; const LAS float* s = scr + (8 * c) * 33 + n;
        u32x4 o;
        if (f16out) { o.x = pkh(s[0 * 33] * scale, s[1 * 33] * scale); o.y = pkh(s[2 * 33] * scale, s[3 * 33] * scale); o.z = pkh(s[4 * 33] * scale, s[5 * 33] * scale); o.w = pkh(s[6 * 33] * scale, s[7 * 33] * scale); }
        else { o.x = cvt_pk_bf16(s[0 * 33] * scale, s[1 * 33] * scale); o.y = cvt_pk_bf16(s[2 * 33] * scale, s[3 * 33] * scale); o.z = cvt_pk_bf16(s[4 * 33] * scale, s[5 * 33] * scale); o.w = cvt_pk_bf16(s[6 * 33] * scale, s[7 * 33] * scale); }
        *(u32x4*)(WT + (size_t)rm(n0 + n) * K + k0 + 8 * c) = o; }
    LDS_WAIT();
}
__device__ __forceinline__ void f8_item_load(const float* W, int N, int nblk, int item, int lane, f32x4 (&v)[16]) {
    const int kb = item / nblk, nb = item % nblk, k0 = 64 * kb, n0 = 64 * nb, n4 = lane & 15, kr = lane >> 4;
#pragma unroll
    for (int i = 0; i < 16; ++i) v[i] = *(const f32x4*)(W + (size_t)(k0 + 4 * i + kr) * N + n0 + 4 * n4);
}
template <class RowMap>
__device__ __forceinline__ void f8_item_finish(const f32x4 (&v)[16], int K, int nblk, unsigned char* WT, const RowMap& rm, float scale, LAS float* scr, int item, int lane) {
    const int kb = item / nblk, nb = item % nblk, k0 = 64 * kb, n0 = 64 * nb, n4 = lane & 15, kr = lane >> 4;
#pragma unroll
    for (int i = 0; i < 16; ++i)
#pragma unroll
        for (int j = 0; j < 4; ++j) scr[(4 * n4 + j) * 65 + 4 * i + kr] = v[i][j] * scale;
    LDS_WAIT();
    const int c = lane & 3;
#pragma unroll
    for (int it = 0; it < 4; ++it) {
        const int n = 16 * it + (lane >> 2); const LAS float* s = scr + n * 65 + 16 * c;
        u32x4 o; o.x = pk4_fp8(s[0], s[1], s[2], s[3]); o.y = pk4_fp8(s[4], s[5], s[6], s[7]); o.z = pk4_fp8(s[8], s[9], s[10], s[11]); o.w = pk4_fp8(s[12], s[13], s[14], s[15]);
        *(u32x4*)(WT + (size_t)rm(n0 + n) * K + k0 + 16 * c) = o;
    }
    LDS_WAIT();
}
__device__ __forceinline__ void f8r_item_load(const float* W, int N, int nblk, int item, int lane, f32x4 (&v)[16]) {
    const int kb = item / nblk, nb = item % nblk, k0 = 128 * kb + 16 * (lane >> 3), n0 = 32 * nb + 4 * (lane & 7);
#pragma unroll
    for (int i = 0; i < 16; ++i) v[i] = *(const f32x4*)(W + (size_t)(k0 + i) * N + n0);
}
template <class RowMap>
__device__ __forceinline__ void f8r_item_store(const f32x4 (&v)[16], int K, int nblk, unsigned char* WT, const RowMap& rm, float scale, int item, int lane) {
    const int kb = item / nblk, nb = item % nblk, k0 = 128 * kb + 16 * (lane >> 3), n0 = 32 * nb + 4 * (lane & 7);
#pragma unroll
    for (int j = 0; j < 4; ++j) {
        u32x4 o; o.x = pk4_fp8(v[0][j] * scale, v[1][j] * scale, v[2][j] * scale, v[3][j] * scale); o.y = pk4_fp8(v[4][j] * scale, v[5][j] * scale, v[6][j] * scale, v[7][j] * scale);
        o.z = pk4_fp8(v[8][j] * scale, v[9][j] * scale, v[10][j] * scale, v[11][j] * scale); o.w = pk4_fp8(v[12][j] * scale, v[13][j] * scale, v[14][j] * scale, v[15][j] * scale);
        *(u32x4*)(WT + (size_t)rm(n0 + j) * K + k0) = o;
    }
}
struct RmId { __device__ __forceinline__ int operator()(int n) const { return n; } };
struct RmWin { __device__ __forceinline__ int operator()(int n) const {
    if (n >= 4352) { const int gl = n >= 5376, c = n - (gl ? 5376 : 4352); return 4352 + (c >> 7) * 256 + gl * 128 + (c & 127); }
    if (n >= 1536) return n; const int nl = n & 255; return (n & ~255) + 128 * ((nl >> 5) & 1) + 32 * (nl >> 6) + (nl & 31); } };
struct RmGU { int up; __device__ __forceinline__ int operator()(int n) const { return (n >> 7) * 256 + up * 128 + (n & 127); } };

struct Ptrs {
    const float *x, *c; const int* positions; const float *w_ada, *b_ada, *norm1_w, *w_in, *q_norm_w, *k_norm_w, *conv_w, *conv_b, *lru_w_a, *lru_b_a, *lru_w_x, *lru_b_x, *lru_lambda,
        *w_attn_branch, *w_lru_branch, *w_out, *norm2_w, *w_router, *w_gate, *w_up, *w_down;
    float* out; unsigned char* ws;
};

constexpr int EXPERT_ITEMS_EARLY = 7, EXPERT_ITEMS_ALL = 12;
__device__ __forceinline__ void convert_expert_items(const Frame& F, const Ptrs& P, int j0, int j1) {
    const int gw = F.vcu * NWAVES + F.wave, NGW = F.G * NWAVES;
    constexpr int PER_E = 1536, NIT = 16 * PER_E;
    const float sgu = (float)(1 << WGU_SCALE_LOG2), sd = (float)(1 << WD_SCALE_LOG2);
#define F8_SRC(it, W_, N_, nblk_, r_) const int e_##r_ = (it) / PER_E, q_##r_ = (it) % PER_E, kind_##r_ = q_##r_ >> 9, r_ = q_##r_ & 511; \
    const float* W_ = (kind_##r_ == 0 ? wg_ : kind_##r_ == 1 ? wu_ : wd_) + (size_t)e_##r_ * DM * FF; const int N_ = kind_##r_ == 2 ? DM : FF, nblk_ = N_ / 32
    const float *wg_ = P.w_gate, *wu_ = P.w_up, *wd_ = P.w_down;
    asm volatile("" : "+s"(wg_), "+s"(wu_), "+s"(wd_));
    f32x4 va[16], vb[16];
    int it = gw + j0 * NGW;
    if (j0 < j1 && it < NIT) { F8_SRC(it, W0, N0, nb0, r0); f8r_item_load(W0, N0, nb0, r0, F.lane, va); }
    for (int j = j0; j < j1 && it < NIT; ++j, it += NGW) {
        const int itn = it + NGW;
        if (j + 1 < j1 && itn < NIT) { F8_SRC(itn, W1, N1, nb1, r1); f8r_item_load(W1, N1, nb1, r1, F.lane, vb); }
        {
            const int e = it / PER_E, q = it % PER_E, kind = q >> 9, r = q & 511;
            if (kind == 0) f8r_item_store(va, DM, FF / 32, (unsigned char*)(P.ws + WS_WGU) + (size_t)e * 4096 * DM, RmGU{0}, sgu * -LOG2E, r, F.lane);
            else if (kind == 1) f8r_item_store(va, DM, FF / 32, (unsigned char*)(P.ws + WS_WGU) + (size_t)e * 4096 * DM, RmGU{1}, sgu * -LN2, r, F.lane);
            else f8r_item_store(va, FF, DM / 32, (unsigned char*)(P.ws + WS_WD) + (size_t)e * DM * FF, RmId{}, sd, r, F.lane);
        }
#pragma unroll
        for (int i = 0; i < 16; ++i) va[i] = vb[i];
    }
#undef F8_SRC
}

__device__ __forceinline__ void phase_prologue(const Frame& F, const Ptrs& P) {
    float* mod = (float*)(P.ws + WS_MOD);
    if (F.vcu < 96) {
        LAS float* cT = (LAS float*)F.lds;
        LAS float* red = (LAS float*)(F.lds + 65536);
        {   float cv_[32];
#pragma unroll
            for (int q = 0; q < 32; ++q) cv_[q] = P.c[F.tid + NTHR * q];
#pragma unroll
            for (int q = 0; q < 32; ++q) { const int i = F.tid + NTHR * q, b = i >> 10, k = i & 1023; cT[k * 16 + b] = cv_[q] * sigmoidf_(cv_[q]); } }
        __syncthreads();
        const int col0 = 64 * F.vcu;
        float acc[16];
#pragma unroll
        for (int b = 0; b < 16; ++b) acc[b] = 0.f;
        const float* wp = P.w_ada + (size_t)(F.wave * 128) * 6144 + col0 + F.lane;
        float wa[32], wb[32];
#pragma unroll
        for (int q = 0; q < 32; ++q) wa[q] = wp[(size_t)q * 6144];
#pragma unroll
        for (int bt = 0; bt < 4; ++bt) {
            if (bt < 3) {
#pragma unroll
                for (int q = 0; q < 32; ++q) wb[q] = wp[(size_t)(32 * (bt + 1) + q) * 6144];
            }
#pragma unroll
            for (int q = 0; q < 32; ++q) {
                const int k = F.wave * 128 + 32 * bt + q; const float wv = wa[q];
                const LAS f32x4* cp = (const LAS f32x4*)(cT + k * 16);
#pragma unroll
                for (int qq = 0; qq < 4; ++qq) { const f32x4 cv = cp[qq]; acc[4 * qq] += cv[0] * wv; acc[4 * qq + 1] += cv[1] * wv; acc[4 * qq + 2] += cv[2] * wv; acc[4 * qq + 3] += cv[3] * wv; }
            }
#pragma unroll
            for (int q = 0; q < 32; ++q) wa[q] = wb[q];
        }
#pragma unroll
        for (int b = 0; b < 16; ++b) red[(F.wave * 16 + b) * 64 + F.lane] = acc[b];
        __syncthreads();
        for (int o = F.tid; o < 1024; o += NTHR) { const int b = o >> 6, cl = o & 63; float s = P.b_ada[col0 + cl];
#pragma unroll
            for (int w = 0; w < 8; ++w) s += red[(w * 16 + b) * 64 + cl];
            mod[b * 6144 + col0 + cl] = s; }
        __syncthreads();
    }
    {
        float* cs = (float*)(P.ws + WS_ROPE);
        const int e0_ = F.vcu * NTHR + F.tid, estr_ = F.G * NTHR;
        for (int eb = e0_; eb < NT * 32; eb += 8 * estr_) {
          int pos_[8];
#pragma unroll
          for (int q = 0; q < 8; ++q) { const int e = eb + q * estr_; pos_[q] = e < NT * 32 ? P.positions[e >> 5] : 0; }
#pragma unroll
          for (int q = 0; q < 8; ++q) {
            const int e = eb + q * estr_; if (e >= NT * 32) break;
            const int r = e >> 5, d = e & 31;
            const float inv = exp2f(-(float)d * (13.287712379549449f / 32.0f));
            const float ang = (float)pos_[q] * inv;
            const double rev = (double)ang * 0.15915494309189535; const float fr = (float)(rev - rint(rev));
            cs[(size_t)r * 64 + d] = __builtin_amdgcn_cosf(fr); cs[(size_t)r * 64 + 32 + d] = __builtin_amdgcn_sinf(fr);
          }
        }
    }
    {
        LAS float* scr = (LAS float*)(F.lds + F.wave * 16640);
        const int gw = F.vcu * NWAVES + F.wave, NGW = F.G * NWAVES;
        constexpr int I_IN = 16 * 128, I_AB = 4 * 32, I_LB = 16 * 32, I_OUT = 16 * 32, I_LRU = 128, I_IN8 = 16 * 36;
        constexpr int NITEMS = I_IN + I_AB + I_LB + I_OUT + I_LRU + I_IN8;
        for (int it = gw; it < NITEMS; it += NGW) {
            int r = it;
            if (r >= NITEMS - I_IN8) {
                r -= NITEMS - I_IN8; const int kb = r / 36, nb = r % 36; f32x4 v16[16];
                f8_item_load(P.w_in, NIN, NIN / 64, kb * (NIN / 64) + nb, F.lane, v16);
                f8_item_finish(v16, DM, NIN / 64, (unsigned char*)(P.ws + WS_WIN8), RmWin{}, (float)(1 << WIN_SCALE_LOG2), (LAS float*)(F.lds + F.wave * 16640), kb * (NIN / 64) + nb, F.lane); continue; }
            if (r < I_IN) { transpose_item(P.w_in, DM, NIN, (bf16_t*)(P.ws + WS_WIN), RmWin{}, scr, (r >> 7) * 200 + 72 + (r & 127), F.lane); continue; } r -= I_IN;
            if (r < I_AB) { transpose_item(P.w_attn_branch, 256, DM, (bf16_t*)(P.ws + WS_WAB), RmId{}, scr, r, F.lane); continue; } r -= I_AB;
            if (r < I_LB) { transpose_item(P.w_lru_branch, DM, DM, (bf16_t*)(P.ws + WS_WLB), RmId{}, scr, r, F.lane); continue; } r -= I_LB;
            if (r < I_OUT) { transpose_item(P.w_out, DM, DM, (bf16_t*)(P.ws + WS_WOUT), RmId{}, scr, r, F.lane); continue; } r -= I_OUT;
            { const int blkid = r >> 1, sub = r & 1;
              const int gate = blkid >> 5, dir = (blkid >> 4) & 1, blk = blkid & 15;
              const float* src = (gate ? P.lru_w_x : P.lru_w_a) + (size_t)(dir * 16 + blk) * 4096;
              bf16_t* dst = (bf16_t*)(P.ws + WS_WLRU) + (size_t)(((dir * 16 + blk) * 2 + gate) * 64) * 64;
              transpose_item(src, 64, 64, dst, RmId{}, scr, sub, F.lane, -LOG2E, true); }
        }
    }
}

__device__ __forceinline__ void phase_h1(const Frame& F, const Ptrs& P) {
    const float* mod = (const float*)(P.ws + WS_MOD);
    bf16_t* h1 = (bf16_t*)((unsigned char*)P.out + DO_H1);
    const int gw = F.vcu * NWAVES + F.wave, NGW = F.G * NWAVES;
    const int rpw = (NT + NGW - 1) / NGW, r0 = gw * rpw, r1 = (r0 + rpw < NT) ? r0 + rpw : NT;
    f32x4 nw[4];
#pragma unroll
    for (int j = 0; j < 4; ++j) nw[j] = *(const f32x4*)(P.norm1_w + 256 * j + 4 * F.lane);
    f32x4 v[4], vn[4], sh[4], sc[4];
    int bcur = -1;
    if (r0 < r1) {
#pragma unroll
        for (int j = 0; j < 4; ++j) v[j] = ((const f32x4*)(P.x + (size_t)r0 * DM) + F.lane)[64 * j];
    }
    for (int r = r0; r < r1; ++r) {
        const int b = r >> 12, rn = r + 1;
        if (rn < r1) {
#pragma unroll
            for (int j = 0; j < 4; ++j) vn[j] = ((const f32x4*)(P.x + (size_t)rn * DM) + F.lane)[64 * j];
        }
        if (b != bcur) { bcur = b;
#pragma unroll
            for (int j = 0; j < 4; ++j) { const int k = 256 * j + 4 * F.lane; sh[j] = *(const f32x4*)(mod + b * 6144 + k); sc[j] = *(const f32x4*)(mod + b * 6144 + 1024 + k) + 1.0f; } }
        float s = 0.f;
#pragma unroll
        for (int j = 0; j < 4; ++j) s += v[j][0] * v[j][0] + v[j][1] * v[j][1] + v[j][2] * v[j][2] + v[j][3] * v[j][3];
        const float rs = __builtin_amdgcn_rsqf(wave_sum(s) * (1.0f / DM) + NORM_EPS);
        u32x2* o = (u32x2*)(h1 + (size_t)r * DM) + F.lane;
#pragma unroll
        for (int j = 0; j < 4; ++j) {
            const f32x4 y = v[j] * rs * nw[j] * sc[j] + sh[j];
            u32x2 pk; pk.x = cvt_pk_bf16(y[0], y[1]); pk.y = cvt_pk_bf16(y[2], y[3]); o[64 * j] = pk;
            ((unsigned*)((unsigned char*)P.out + DO_H18 + (size_t)r * DM) + F.lane)[64 * j] = pk4_fp8(y[0], y[1], y[2], y[3]);
        }
#pragma unroll
        for (int j = 0; j < 4; ++j) v[j] = vn[j];
    }
}

constexpr int VPITCH = 144;
__device__ __forceinline__ s16x4 vtr(const LAS unsigned char* p) { return __builtin_bit_cast(s16x4, __builtin_amdgcn_ds_read_tr16_b64_v4i16((LAS v4i16_t*)p)); }
typedef __bf16 bf16v2_t __attribute__((ext_vector_type(2)));
__device__ __forceinline__ void expand_fp8x16(const u32x4 in, u32x4& o0, u32x4& o1) {
    const unsigned w[4] = {in.x, in.y, in.z, in.w}; unsigned o[8];
#pragma unroll
    for (int i = 0; i < 4; ++i) { o[2 * i] = __builtin_bit_cast(unsigned, __builtin_amdgcn_cvt_scalef32_pk_bf16_fp8(w[i], 1.0f, false)); o[2 * i + 1] = __builtin_bit_cast(unsigned, __builtin_amdgcn_cvt_scalef32_pk_bf16_fp8(w[i], 1.0f, true)); }
    o0 = (u32x4){o[0], o[1], o[2], o[3]}; o1 = (u32x4){o[4], o[5], o[6], o[7]};
}
constexpr int AT_K = 0, AT_V = 384 * VPITCH, AT_O = 2 * 384 * VPITCH;
__device__ __forceinline__ void phase_attn(const Frame& F, const Ptrs& P) {
    const bf16_t* QG = (const bf16_t*)(P.ws + WS_QG); const bf16_t* KG = (const bf16_t*)(P.ws + WS_KG); const bf16_t* VG = (const bf16_t*)(P.ws + WS_VG);
    bf16_t* OG = (bf16_t*)((unsigned char*)P.out + DO_OG); float* LSE = (float*)(P.ws + WS_LSE);
    LAS unsigned char* kl = F.lds + AT_K; LAS unsigned char* vl = F.lds + AT_V;
    const int lane = F.lane, r31 = lane & 31, h = lane >> 5, w = F.wave;
    const int i16 = lane & 15, tq = i16 >> 2, tp = i16 & 3, dblk = (lane >> 4) & 1;
    const int prow = F.tid >> 2, pc4 = F.tid & 3;
    const unsigned char* K8 = (const unsigned char*)KG; const unsigned char* V8 = (const unsigned char*)VG;
    constexpr int NITEM = 3 * 4 * 256;
#define AT_DECODE(IT, g_, j_, Lg_, row0_, s0_, m0_, off_) const int g_ = (IT) >> 10, j_ = ((IT) >> 8) & 3, Lg_ = SEQ >> (2 * g_), row0_ = ((IT) & 255) * 256, s0_ = row0_ & ~(Lg_ - 1), m0_ = row0_ - s0_; \
        const size_t off_ = (size_t)g_ * NT * 256 + j_ * 64
    u32x4 kr[3], vr[3]; bf16x8 qf[4];
#define AT_LOAD(s0_, m0_, Lg_, off_, row0_) do { _Pragma("unroll") for (int i = 0; i < 3; ++i) { int kk_ = (m0_) - 64 + prow + 128 * i; kk_ = kk_ < 0 ? 0 : (kk_ > (Lg_) - 1 ? (Lg_) - 1 : kk_); \
            const size_t o_ = (off_) + (size_t)((s0_) + kk_) * 256 + 16 * pc4; kr[i] = *(const u32x4*)(K8 + o_); vr[i] = *(const u32x4*)(V8 + o_); } \
        _Pragma("unroll") for (int s = 0; s < 4; ++s) qf[s] = *(const bf16x8*)(QG + (off_) + (size_t)((row0_) + 32 * w + r31) * 256 + 16 * s + 8 * h); } while (0)
    if ((int)F.vcu < NITEM) { AT_DECODE(F.vcu, g, j, Lg, row0, s0, m0, off); AT_LOAD(s0, m0, Lg, off, row0); }
    for (int it = F.vcu; it < NITEM; it += F.G) {
        AT_DECODE(it, g, j, Lg, row0, s0, m0, off);
        __syncthreads();
#pragma unroll
        for (int i = 0; i < 3; ++i) { u32x4 a0, a1, b0, b1; expand_fp8x16(kr[i], a0, a1); expand_fp8x16(vr[i], b0, b1);
            LAS unsigned char* kd = kl + (prow + 128 * i) * VPITCH + 32 * pc4; LAS unsigned char* vd = vl + (prow + 128 * i) * VPITCH + 32 * pc4;
            *(LAS u32x4*)(kd) = a0; *(LAS u32x4*)(kd + 16) = a1; *(LAS u32x4*)(vd) = b0; *(LAS u32x4*)(vd + 16) = b1; }
        bf16x8 qc[4];
#pragma unroll
        for (int s = 0; s < 4; ++s) qc[s] = qf[s];
        __syncthreads();
        { const int itn = it + F.G; if (itn < NITEM) { AT_DECODE(itn, gn, jn, Lgn, row0n, s0n, m0n, offn); AT_LOAD(s0n, m0n, Lgn, offn, row0n); } }
        f32x16 st[5];
        float mx = -3.0e38f;
        const int rh = r31 - 4 * h;
#pragma unroll
        for (int kt = 0; kt < 5; ++kt) {
            const int kb = m0 - 64 + 32 * (w + kt);
            bf16x8 kc[4];
#pragma unroll
            for (int s = 0; s < 4; ++s) kc[s] = *(const LAS bf16x8*)(kl + (32 * (w + kt) + r31) * VPITCH + (16 * s + 8 * h) * 2);
            f32x16 a;
#pragma unroll
            for (int i = 0; i < 16; ++i) a[i] = 0.f;
#pragma unroll
            for (int s = 0; s < 4; ++s) a = __builtin_amdgcn_mfma_f32_32x32x16_bf16(kc[s], qc[s], a, 0, 0, 0);
            if (!((kb >= 0) && (kb < Lg))) {
#pragma unroll
                for (int i = 0; i < 16; ++i) a[i] = -1.0e30f;
            } else if (kt == 0) {
#pragma unroll
                for (int i = 0; i < 16; ++i) a[i] = ((i & 3) + 8 * (i >> 2) >= rh) ? a[i] : -1.0e30f;
            } else if (kt == 4) {
#pragma unroll
                for (int i = 0; i < 16; ++i) a[i] = ((i & 3) + 8 * (i >> 2) <= rh) ? a[i] : -1.0e30f;
            }
#pragma unroll
            for (int i = 0; i < 16; ++i) mx = fmaxf(mx, a[i]);
            st[kt] = a;
        }
        { const auto t_ = __builtin_amdgcn_permlane32_swap(__float_as_uint(mx), __float_as_uint(mx), false, false); mx = fmaxf(__uint_as_float(t_[0]), __uint_as_float(t_[1])); }
        float lsum = 0.f;
#pragma unroll
        for (int kt = 0; kt < 5; ++kt)
#pragma unroll
            for (int i = 0; i < 16; ++i) { const float p = fast_exp2(st[kt][i] - mx); st[kt][i] = p; lsum += p; }
        { const auto t_ = __builtin_amdgcn_permlane32_swap(__float_as_uint(lsum), __float_as_uint(lsum), false, false); lsum = __uint_as_float(t_[0]) + __uint_as_float(t_[1]); }
        f32x16 o0, o1;
#pragma unroll
        for (int i = 0; i < 16; ++i) { o0[i] = 0.f; o1[i] = 0.f; }
#pragma unroll
        for (int kt = 0; kt < 5; ++kt) {
            const LAS unsigned char* vt = vl + 32 * (w + kt) * VPITCH;
#pragma unroll
            for (int s2 = 0; s2 < 2; ++s2) {
                u32x4 pp; pp.x = cvt_pk_bf16(st[kt][8 * s2], st[kt][8 * s2 + 1]); pp.y = cvt_pk_bf16(st[kt][8 * s2 + 2], st[kt][8 * s2 + 3]);
                pp.z = cvt_pk_bf16(st[kt][8 * s2 + 4], st[kt][8 * s2 + 5]); pp.w = cvt_pk_bf16(st[kt][8 * s2 + 6], st[kt][8 * s2 + 7]);
                const bf16x8 pf = __builtin_bit_cast(bf16x8, pp);
#pragma unroll
                for (int dt = 0; dt < 2; ++dt) {
                    const LAS unsigned char* base = vt + (16 * s2 + 4 * h + tq) * VPITCH + (32 * dt + 16 * dblk + 4 * tp) * 2;
                    const s16x4 lo = vtr(base), hi = vtr(base + 8 * VPITCH);
                    const bf16x8 vf = __builtin_shufflevector(lo, hi, 0, 1, 2, 3, 4, 5, 6, 7);
                    if (dt == 0) o0 = __builtin_amdgcn_mfma_f32_32x32x16_bf16(vf, pf, o0, 0, 0, 0);
                    else o1 = __builtin_amdgcn_mfma_f32_32x32x16_bf16(vf, pf, o1, 0, 0, 0);
                }
            }
        }
        const float inv = fast_rcp(lsum);
        LAS unsigned char* ot = F.lds + AT_O + w * (32 * VPITCH);
#pragma unroll
        for (int q = 0; q < 4; ++q) {
            u32x2 w0, w1;
            w0.x = cvt_pk_bf16(o0[4 * q] * inv, o0[4 * q + 1] * inv); w0.y = cvt_pk_bf16(o0[4 * q + 2] * inv, o0[4 * q + 3] * inv);
            w1.x = cvt_pk_bf16(o1[4 * q] * inv, o1[4 * q + 1] * inv); w1.y = cvt_pk_bf16(o1[4 * q + 2] * inv, o1[4 * q + 3] * inv);
            *(LAS u32x2*)(ot + r31 * VPITCH + (8 * q + 4 * h) * 2) = w0; *(LAS u32x2*)(ot + r31 * VPITCH + (32 + 8 * q + 4 * h) * 2) = w1;
        }
        LDS_WAIT();
        {
            bf16_t* ob = OG + off + (size_t)(row0 + 32 * w) * 256;
#pragma unroll
            for (int i = 0; i < 4; ++i) { const int c = lane + 64 * i, rr = c >> 3, c8 = c & 7; *(u32x4*)(ob + (size_t)rr * 256 + 8 * c8) = *(const LAS u32x4*)(ot + rr * VPITCH + 16 * c8); }
        }
        if (h == 0) LSE[((size_t)g * NT + row0 + 32 * w + r31) * 4 + j] = LN2 * (mx + __builtin_amdgcn_logf(lsum));
    }
#undef AT_DECODE
#undef AT_LOAD
}

__device__ __forceinline__ void phase_combine(const Frame& F, const Ptrs& P) {
    const bf16_t* OG = (const bf16_t*)((unsigned char*)P.out + DO_OG); const float* LSE = (const float*)(P.ws + WS_LSE);
    bf16_t* AT = (bf16_t*)(P.ws + WS_ATTN);
    const int gw = F.vcu * NWAVES + F.wave, NGW = F.G * NWAVES, j = F.lane >> 4;
    for (int rb = gw; rb < NT; rb += 4 * NGW) {
        float l[4][3]; u32x2 o[4][3];
#pragma unroll
        for (int q = 0; q < 4; ++q) { const int r = rb + q * NGW;
            if (r < NT) {
#pragma unroll
                for (int g = 0; g < 3; ++g) { const int rp = perm_row(r, 2 * g); l[q][g] = LSE[((size_t)g * NT + rp) * 4 + j]; o[q][g] = *(const u32x2*)(OG + ((size_t)g * NT + rp) * 256 + 4 * F.lane); } } }
#pragma unroll
        for (int q = 0; q < 4; ++q) { const int r = rb + q * NGW;
            if (r < NT) {
                const float m = fmaxf(l[q][0], fmaxf(l[q][1], l[q][2]));
                float w[3]; float s = 0.f;
#pragma unroll
                for (int g = 0; g < 3; ++g) { w[g] = fast_exp2((l[q][g] - m) * LOG2E); s += w[g]; }
                const float inv = fast_rcp(s);
                float a0 = 0.f, a1 = 0.f, a2 = 0.f, a3 = 0.f;
#pragma unroll
                for (int g = 0; g < 3; ++g) { const float ww = w[g] * inv; a0 += ww * bflo(o[q][g].x); a1 += ww * bfhi(o[q][g].x); a2 += ww * bflo(o[q][g].y); a3 += ww * bfhi(o[q][g].y); }
                u32x2 pk; pk.x = cvt_pk_bf16(a0, a1); pk.y = cvt_pk_bf16(a2, a3);
                *(u32x2*)(AT + (size_t)r * 256 + 4 * F.lane) = pk;
            } }
    }
}

struct CombTrip { float l[4][3]; u32x2 o[4][3]; };
__device__ __forceinline__ void combine_trip_load(const Frame& F, const Ptrs& P, int trip, CombTrip& c) {
    const bf16_t* OG = (const bf16_t*)((unsigned char*)P.out + DO_OG); const float* LSE = (const float*)(P.ws + WS_LSE);
    const int gw = F.vcu * NWAVES + F.wave, NGW = F.G * NWAVES, j = F.lane >> 4;
#pragma unroll
    for (int q = 0; q < 4; ++q) { int r = gw + (4 * trip + q) * NGW; r = r < NT ? r : NT - 1;
#pragma unroll
        for (int g = 0; g < 3; ++g) { const int rp = perm_row(r, 2 * g); c.l[q][g] = LSE[((size_t)g * NT + rp) * 4 + j]; c.o[q][g] = *(const u32x2*)(OG + ((size_t)g * NT + rp) * 256 + 4 * F.lane); } }
}
__device__ __forceinline__ void combine_trip_finish(const Frame& F, const Ptrs& P, int trip, const CombTrip& c) {
    bf16_t* AT = (bf16_t*)(P.ws + WS_ATTN);
    const int gw = F.vcu * NWAVES + F.wave, NGW = F.G * NWAVES;
#pragma unroll
    for (int q = 0; q < 4; ++q) { const int r = gw + (4 * trip + q) * NGW;
        if (r < NT) {
            const float m = fmaxf(c.l[q][0], fmaxf(c.l[q][1], c.l[q][2]));
            float w[3]; float s = 0.f;
#pragma unroll
            for (int g = 0; g < 3; ++g) { w[g] = fast_exp2((c.l[q][g] - m) * LOG2E); s += w[g]; }
            const float inv = fast_rcp(s);
            float a0 = 0.f, a1 = 0.f, a2 = 0.f, a3 = 0.f;
#pragma unroll
            for (int g = 0; g < 3; ++g) { const float ww = w[g] * inv; a0 += ww * bflo(c.o[q][g].x); a1 += ww * bfhi(c.o[q][g].x); a2 += ww * bflo(c.o[q][g].y); a3 += ww * bfhi(c.o[q][g].y); }
            u32x2 pk; pk.x = cvt_pk_bf16(a0, a1); pk.y = cvt_pk_bf16(a2, a3);
            *(u32x2*)(AT + (size_t)r * 256 + 4 * F.lane) = pk;
        } }
}
constexpr int COMB_TRIPS_PER_UNIT = 8;
constexpr int TPITCH = 144;
constexpr int LRU_XRT = 0;
constexpr int LRU_XC = 37376;
constexpr int LRU_OUT = 74240;
constexpr int LRU_W = 111104;
constexpr int LRU_CMP = 129536;
constexpr int LRU_CARRY = 133632;
constexpr int LRU_CONV = 134144;
__device__ __forceinline__ int probe_reps(bool on) { int n = on ? 2 : 1; asm volatile("" : "+s"(n)); return n; }
__device__ __forceinline__ void probe_fence() { asm volatile("" ::: "memory"); }
#ifdef LRU_PROBE_STAGE
#define LRU_PROBE_LOOP(k) _Pragma("nounroll") for (int rep_ = 0, nrep_ = probe_reps((k) == LRU_PROBE_STAGE); rep_ < nrep_; ++rep_, probe_fence())
#else
#define LRU_PROBE_LOOP(k)
#endif
template <bool B> struct BoolC { static constexpr bool value = B; };
constexpr int LT_TOK = 128;
constexpr int LT_XRT = 0, LT_XC = 20224, LT_OUT = LT_XC + 18432, LT_W = LT_OUT + 18432, LT_CMP = LT_W + 18432, LT_CARRY = LT_CMP + 2048, LT_CONV = LT_CARRY + 512, LT_SIZE = LT_CONV + 640;
static_assert(2 * LT_SIZE <= 163840 - 256, "LRU LDS");
template <int DIR>
__device__ __forceinline__ void lru_team(const Frame& F, const Ptrs& P, int b, int blk, const int trip0, const int ntrips) {
    const bf16_t* XR = (const bf16_t*)(P.ws + WS_XR); const bf16_t* GY = (const bf16_t*)(P.ws + WS_GY);
    bf16_t* HF = (bf16_t*)((unsigned char*)P.out + DO_HF); bf16_t* LR = (bf16_t*)(P.ws + WS_LRU);
    const bf16_t* WL = (const bf16_t*)(P.ws + WS_WLRU) + (size_t)((DIR * 16 + blk) * 2) * 4096;
    LAS unsigned char* tb_ = F.lds + DIR * LT_SIZE;
    LAS unsigned char* xrt = tb_ + LT_XRT + (F.wave & 3) * 35 * TPITCH; LAS unsigned char* xcb = tb_ + LT_XC; LAS unsigned char* outt = tb_ + LT_OUT; LAS unsigned char* wl = tb_ + LT_W;
    LAS float* cmp = (LAS float*)(tb_ + LT_CMP); LAS float* carry = (LAS float*)(tb_ + LT_CARRY); LAS unsigned char* cvb = tb_ + LT_CONV;
    const int lane = F.lane, r31 = lane & 31, h = lane >> 5, w = F.wave & 3, ttid = F.tid & 255;
    const int ch0 = blk * 64, cc = lane & 7, tl0 = 32 * w + (lane >> 3);
    const size_t gcol = (size_t)ch0 + 8 * cc;
    for (int i = ttid; i < 1024; i += 256) { const int row = i >> 3, ch8 = i & 7; *(LAS u32x4*)(wl + row * TPITCH + 16 * ch8) = *(const u32x4*)(WL + (size_t)row * 64 + 8 * ch8); }
    for (int i = ttid; i < 320; i += 256) { const int jj = i >> 6, ch = i & 63; *(LAS _Float16*)(cvb + i * 2) = (_Float16)(jj < 4 ? P.conv_w[jj * 1024 + ch0 + ch] : P.conv_b[ch0 + ch]); }
    if (ttid < 128) carry[ttid] = 0.f;
    float ba[2], bx[2], cl[2];
#pragma unroll
    for (int c2 = 0; c2 < 2; ++c2) { const int ch = ch0 + 32 * c2 + r31;
        ba[c2] = fast_exp2(fminf(fmaxf(-LOG2E * P.lru_b_a[DIR * 1024 + ch], -100.f), 100.f)); bx[c2] = fast_exp2(fminf(fmaxf(-LOG2E * P.lru_b_x[DIR * 1024 + ch], -100.f), 100.f));
        const float lam = P.lru_lambda[DIR * 1024 + ch];
        const float sp = (lam > 15.f) ? __expf(-lam) : ((lam < -15.f) ? -lam : log1pf(__expf(-lam)));
        cl[c2] = -8.0f * sp * LOG2E; }
    u32x4 xrp[4], xrh = (u32x4){0u, 0u, 0u, 0u}, hfp[4], gyp[4];
#define LRU_LOAD_XR(T0) do { _Pragma("unroll") for (int i = 0; i < 4; ++i) xrp[i] = *(const u32x4*)(XR + (size_t)(b * SEQ + (T0) + tl0 + 8 * i) * 1024 + gcol); \
        int tz_ = lane; asm volatile("" : "+v"(tz_));     \
        if (tz_ < 24) { const int hr = tz_ >> 3; const int th = hr < 2 ? (T0) + 32 * w - 2 + hr : (T0) + 32 * w + 32; xrh = (u32x4){0u, 0u, 0u, 0u}; if (th >= 0 && th < SEQ) xrh = *(const u32x4*)(XR + (size_t)(b * SEQ + th) * 1024 + ch0 + 8 * (tz_ & 7)); } } while (0)
#define LRU_LOAD_HG(T0) do { _Pragma("unroll") for (int i = 0; i < 4; ++i) { const size_t o = (size_t)(b * SEQ + (T0) + tl0 + 8 * i) * 1024 + gcol; hfp[i] = *(const u32x4*)(HF + o); gyp[i] = *(const u32x4*)(GY + o); } } while (0)
#define LRU_XR_TO_LDS() do { _Pragma("unroll") for (int i = 0; i < 4; ++i) *(LAS u32x4*)(xrt + ((lane >> 3) + 8 * i + 2) * TPITCH + 16 * cc) = xrp[i]; \
        int tz_ = lane; asm volatile("" : "+v"(tz_)); if (tz_ < 24) { const int hr = tz_ >> 3; *(LAS u32x4*)(xrt + (hr < 2 ? hr : 34) * TPITCH + 16 * (tz_ & 7)) = xrh; } } while (0)
    auto conv_stage = [&]() __attribute__((always_inline)) {
        int ln_ = F.lane; asm volatile("" : "+v"(ln_));
        const int lane = ln_, cc = lane & 7, tl0 = 32 * w + (lane >> 3);
        LRU_PROBE_LOOP(3)
        {
            u32x4 cwv[5];
#pragma unroll
            for (int jj = 0; jj < 5; ++jj) cwv[jj] = *(const LAS u32x4*)(cvb + jj * 128 + 16 * cc);
#pragma unroll
            for (int ih = 0; ih < 2; ++ih) {
                u32x4 xv[2][4];
#pragma unroll
                for (int i = 0; i < 2; ++i)
#pragma unroll
                    for (int jj = 0; jj < 4; ++jj) xv[i][jj] = *(const LAS u32x4*)(xrt + ((lane >> 3) + 8 * (2 * ih + i) + jj) * TPITCH + 16 * cc);
                __builtin_amdgcn_sched_barrier(0);
#pragma unroll
                for (int i = 0; i < 2; ++i) {
                    h16x2 x0 = ash2(cwv[4].x), x1 = ash2(cwv[4].y), x2 = ash2(cwv[4].z), x3 = ash2(cwv[4].w);
#pragma unroll
                    for (int jj = 0; jj < 4; ++jj) {
                        x0 = ash2(cwv[jj].x) * ash2(xv[i][jj].x) + x0; x1 = ash2(cwv[jj].y) * ash2(xv[i][jj].y) + x1; x2 = ash2(cwv[jj].z) * ash2(xv[i][jj].z) + x2; x3 = ash2(cwv[jj].w) * ash2(xv[i][jj].w) + x3;
                    }
                    *(LAS u32x4*)(xcb + (tl0 + 8 * (2 * ih + i)) * TPITCH + 16 * cc) = (u32x4){asu(x0), asu(x1), asu(x2), asu(x3)};
                }
                __builtin_amdgcn_sched_barrier(0);
            }
        }
    };
    { const int t00 = DIR ? SEQ - LT_TOK : 0; LRU_LOAD_XR(t00); }
    __syncthreads();
    LRU_XR_TO_LDS();
    conv_stage();
    __syncthreads();
    if (DIR) __syncthreads();
    auto step_body = [&](const int step, auto sec_) __attribute__((always_inline)) {
        int ln_ = F.lane; asm volatile("" : "+v"(ln_));
        const int lane = ln_, r31 = lane & 31, h = lane >> 5, ttid = 64 * w + lane, cc = lane & 7, tl0 = 32 * w + (lane >> 3);
        const size_t gcol = (size_t)ch0 + 8 * cc;
        const int t0 = DIR ? (SEQ - LT_TOK - LT_TOK * step) : LT_TOK * step;
        const int t0n = DIR ? t0 - LT_TOK : t0 + LT_TOK;
        constexpr bool second = decltype(sec_)::value;
        if (step < SEQ / LT_TOK - 1) LRU_LOAD_XR(t0n);
        const int tw = 32 * w;
        h16x8 af[4];
#pragma unroll
        for (int s = 0; s < 4; ++s) af[s] = *(const LAS h16x8*)(xcb + (tw + r31) * TPITCH + (16 * s + 8 * h) * 2);
        float av[2][16], uv[2][16], A0[2], U0[2], A1[2], U1[2];
        LRU_PROBE_LOOP(4)
#pragma unroll
        for (int c2 = 0; c2 < 2; ++c2) {
            f32x16 za, zx;
#pragma unroll
            for (int i = 0; i < 16; ++i) { za[i] = 0.f; zx[i] = 0.f; }
#pragma unroll
            for (int s = 0; s < 4; ++s) {
                const h16x8 wa = *(const LAS h16x8*)(wl + (32 * c2 + r31) * TPITCH + (16 * s + 8 * h) * 2), wx = *(const LAS h16x8*)(wl + (64 + 32 * c2 + r31) * TPITCH + (16 * s + 8 * h) * 2);
                za = __builtin_amdgcn_mfma_f32_32x32x16_f16(af[s], wa, za, 0, 0, 0); zx = __builtin_amdgcn_mfma_f32_32x32x16_f16(af[s], wx, zx, 0, 0, 0);
            }
            f32x16 xcv;
#pragma unroll
            for (int i = 0; i < 16; ++i) xcv[i] = 0.f;
            {   h16x8 sel0, sel1;
#pragma unroll
                for (int j = 0; j < 8; ++j) { sel0[j] = (8 * h + j == r31) ? (_Float16)1.0f : (_Float16)0.0f; sel1[j] = (16 + 8 * h + j == r31) ? (_Float16)1.0f : (_Float16)0.0f; }
                xcv = __builtin_amdgcn_mfma_f32_32x32x16_f16(af[2 * c2], sel0, xcv, 0, 0, 0); xcv = __builtin_amdgcn_mfma_f32_32x32x16_f16(af[2 * c2 + 1], sel1, xcv, 0, 0, 0); }
#pragma unroll
            for (int i = 0; i < 16; ++i) { za[i] = fast_exp2(za[i]); zx[i] = fast_exp2(zx[i]); }
            __builtin_amdgcn_sched_barrier(0);
#pragma unroll
            for (int i = 0; i < 16; ++i) { za[i] = fast_rcp(__builtin_fmaf(za[i], ba[c2], 1.0f)); zx[i] = fast_rcp(__builtin_fmaf(zx[i], bx[c2], 1.0f)); }
            __builtin_amdgcn_sched_barrier(0);
#pragma unroll
            for (int i = 0; i < 16; ++i) za[i] = fast_exp2(cl[c2] * za[i]);
            __builtin_amdgcn_sched_barrier(0);
#pragma unroll
            for (int i = 0; i < 16; ++i) zx[i] = __builtin_amdgcn_sqrtf(__builtin_fmaf(-za[i], za[i], 1.0f)) * (zx[i] * xcv[i]);
            __builtin_amdgcn_sched_barrier(0);
#pragma unroll
            for (int q = 0; q < 2; ++q)
#pragma unroll
                for (int j = 0; j < 4; ++j) {
                    const int i = 4 * q + j;
                    const auto ra = __builtin_amdgcn_permlane32_swap(__float_as_uint(za[i]), __float_as_uint(za[i + 8]), false, false);
                    const auto ru = __builtin_amdgcn_permlane32_swap(__float_as_uint(zx[i]), __float_as_uint(zx[i + 8]), false, false);
                    av[c2][8 * q + j] = __uint_as_float(ra[0]); av[c2][8 * q + 4 + j] = __uint_as_float(ra[1]);
                    uv[c2][8 * q + j] = __uint_as_float(ru[0]); uv[c2][8 * q + 4 + j] = __uint_as_float(ru[1]);
                }
            float A = 1.f, U = 0.f;
#pragma unroll
            for (int e = 0; e < 16; ++e) { const int k = DIR ? 15 - e : e; U = U * av[c2][k] + uv[c2][k]; A *= av[c2][k]; }
            { const auto rA = __builtin_amdgcn_permlane32_swap(__float_as_uint(A), __float_as_uint(A), false, false); A0[c2] = __uint_as_float(rA[0]); A1[c2] = __uint_as_float(rA[1]);
              const auto rU = __builtin_amdgcn_permlane32_swap(__float_as_uint(U), __float_as_uint(U), false, false); U0[c2] = __uint_as_float(rU[0]); U1[c2] = __uint_as_float(rU[1]); }
            const float tA = A0[c2] * A1[c2], tU = DIR ? (U1[c2] * A0[c2] + U0[c2]) : (U0[c2] * A1[c2] + U1[c2]);
            if (h == 0) { cmp[(w * 64 + 32 * c2 + r31) * 2] = tA; cmp[(w * 64 + 32 * c2 + r31) * 2 + 1] = tU; }
            asm volatile("" ::: "memory");
        }
        __syncthreads();
        if (second) LRU_LOAD_HG(t0);
        CombTrip ctr; const int ctrip = trip0 + (step >> 1); const bool cdo = !second && ((step & 1) == 0) && ctrip < ntrips;
        if (!second) { if (cdo) combine_trip_load(F, P, ctrip, ctr); }
        LRU_PROBE_LOOP(5)
#pragma unroll
        for (int c2 = 0; c2 < 2; ++c2) {
            const int ch = 32 * c2 + r31;
            float Hc = carry[(step & 1) * 64 + ch];
            float Hin = Hc;
#pragma unroll
            for (int k = 0; k < 4; ++k) {
                const int ww = DIR ? 3 - k : k;
                const f32x2 cu = *(const LAS f32x2*)(cmp + (ww * 64 + ch) * 2);
                const bool before = DIR ? (ww > w) : (ww < w);
                if (before) Hin = Hin * cu[0] + cu[1];
                Hc = Hc * cu[0] + cu[1];
            }
            if (w == 0 && h == 0) carry[((step + 1) & 1) * 64 + ch] = Hc;
            float hv = DIR ? (h == 1 ? Hin : Hin * A1[c2] + U1[c2]) : (h == 0 ? Hin : Hin * A0[c2] + U0[c2]);
#pragma unroll
            for (int e = 0; e < 16; e += 2) {
                const int k0 = DIR ? 15 - e : e, k1 = DIR ? 14 - e : e + 1;
                hv = hv * av[c2][k0] + uv[c2][k0]; const float h0 = hv;
                hv = hv * av[c2][k1] + uv[c2][k1];
                const h16x2 pr = __builtin_bit_cast(h16x2, __builtin_amdgcn_cvt_pkrtz(h0, hv));
                *(LAS _Float16*)(outt + (tw + 16 * h + k0) * TPITCH + ch * 2) = pr[0];
                *(LAS _Float16*)(outt + (tw + 16 * h + k1) * TPITCH + ch * 2) = pr[1];
            }
            asm volatile("" ::: "memory");
        }
        if (step < SEQ / LT_TOK - 1) { LRU_XR_TO_LDS(); conv_stage(); }
        LRU_PROBE_LOOP(6)
#pragma unroll
        for (int i = 0; i < 4; ++i) {
            const int tl = tl0 + 8 * i; const size_t o = (size_t)(b * SEQ + t0 + tl) * 1024 + gcol;
            const u32x4 hb = *(const LAS u32x4*)(outt + tl * TPITCH + 16 * cc);
            if (!second) *(u32x4*)(HF + o) = hb;
            else {
                const h16x2 p0 = (ash2(hb.x) + ash2(hfp[i].x)) * ash2(gyp[i].x), p1 = (ash2(hb.y) + ash2(hfp[i].y)) * ash2(gyp[i].y), p2 = (ash2(hb.z) + ash2(hfp[i].z)) * ash2(gyp[i].z), p3 = (ash2(hb.w) + ash2(hfp[i].w)) * ash2(gyp[i].w);
                u32x4 ov; ov.x = cvt_pk_bf16((float)p0[0], (float)p0[1]); ov.y = cvt_pk_bf16((float)p1[0], (float)p1[1]); ov.z = cvt_pk_bf16((float)p2[0], (float)p2[1]); ov.w = cvt_pk_bf16((float)p3[0], (float)p3[1]);
                *(u32x4*)(LR + o) = ov;
            }
        }
        if (!second) { if (cdo) combine_trip_finish(F, P, ctrip, ctr); }
        if (step == SEQ / LT_TOK / 2 - 1) VM_WAIT();
        __syncthreads();
    };
#pragma nounroll
    for (int step = 0; step < SEQ / LT_TOK / 2; ++step) step_body(step, BoolC<false>{});
#pragma nounroll
    for (int step = SEQ / LT_TOK / 2; step < SEQ / LT_TOK; ++step) step_body(step, BoolC<true>{});
    if (!DIR) __syncthreads();
#undef LRU_XR_TO_LDS
#undef LRU_LOAD_XR
#undef LRU_LOAD_HG
}
__device__ __forceinline__ void phase_lru(const Frame& F, const Ptrs& P) {
    const int ntrips = (NT + 4 * F.G * NWAVES - 1) / (4 * F.G * NWAVES);
    int trip0 = 0;
    for (int u = F.vcu; u < 256; u += F.G) {
        const int b = u >> 4, blk = u & 15;
        if (F.wave < 4) lru_team<0>(F, P, b, blk, trip0, ntrips); else lru_team<1>(F, P, b, blk, trip0, ntrips);
        trip0 += COMB_TRIPS_PER_UNIT;
        __syncthreads();
    }
    for (int t = trip0; t < ntrips; ++t) { CombTrip c; combine_trip_load(F, P, t, c); combine_trip_finish(F, P, t, c); }
}

#ifdef H2_PROBE_STAGE
#define H2_PROBE_LOOP(k) _Pragma("nounroll") for (int rep_ = 0, nrep_ = probe_reps((k) == H2_PROBE_STAGE); rep_ < nrep_; ++rep_, probe_fence())
#else
#define H2_PROBE_LOOP(k)
#endif
constexpr int H2_RED = 0;
constexpr int H2_SSQ = 16384;
constexpr int H2_BIAS = 17408;
constexpr int H2_AFF = 18432;
constexpr int H2_F8T = 35328;
constexpr int H2_CS = 53760;
constexpr int H2_XT = 65536;
__device__ __forceinline__ void phase_h2(const Frame& F, const Ptrs& P, unsigned char* H2) {
    const float* mod = (const float*)(P.ws + WS_MOD);
    float* AFF = (float*)(P.ws + WS_AFF);
    convert_expert_items(F, P, EXPERT_ITEMS_ALL, 1 << 20);
    __syncthreads();
    LAS float* red = (LAS float*)(F.lds + H2_RED); LAS float* ssq = (LAS float*)(F.lds + H2_SSQ); LAS float* biasp = (LAS float*)(F.lds + H2_BIAS); LAS float* affl = (LAS float*)(F.lds + H2_AFF);
    LAS unsigned char* f8t = F.lds + H2_F8T + F.wave * 2304;
    LAS unsigned char* xt = F.lds + H2_XT + F.wave * 8192;
    const int l = F.lane, r = l & 15, kq = l >> 4, w = F.wave;
    LAS f32x4* csl = (LAS f32x4*)(F.lds + H2_CS) + (w * 4 + kq) * 8;
    const int kb = 128 * w + 4 * kq;
    const int lrow = l >> 5, lq = l & 31;
    H2_PROBE_LOOP(2)
    for (int rb = F.vcu; rb < NT / 256; rb += F.G) {
        const int R0 = rb * 256, b = R0 >> 12, tb = R0 & 4095;
        u32x4 wBh[4], wBl[4], wBm[4];
        float pb = 0.f;
        const int kb2 = 128 * w + 8 * kq;
#pragma unroll
        for (int jh = 0; jh < 2; ++jh) {
            f32x4 nw[4], sc[4], shv[4]; float wrv[4][4];
            const float* wb = P.w_router + (size_t)(kb2 + 64 * jh) * 16 + r; asm volatile("" : "+v"(wb));
#pragma unroll
            for (int j4 = 0; j4 < 4; ++j4) { const int ko = 32 * (j4 >> 1) + 4 * (j4 & 1), k = kb2 + 64 * jh + ko; nw[j4] = *(const f32x4*)(P.norm2_w + k); sc[j4] = *(const f32x4*)(mod + b * 6144 + 4096 + k); shv[j4] = *(const f32x4*)(mod + b * 6144 + 3072 + k);
#pragma unroll
                for (int c = 0; c < 4; ++c) wrv[j4][c] = wb[(ko + c) * 16]; }
            float wf[4][4];
#pragma unroll
            for (int j4 = 0; j4 < 4; ++j4) { const int j = 4 * jh + j4; const f32x4 cmv = nw[j4] * (sc[j4] + 1.0f);
                if (r == 0) { csl[j] = cmv; csl[256 + j] = shv[j4]; }
#pragma unroll
                for (int c = 0; c < 4; ++c) { pb += shv[j4][c] * wrv[j4][c]; wf[j4][c] = cmv[c] * wrv[j4][c]; } }
#pragma unroll
            for (int jb2 = 0; jb2 < 2; ++jb2) {
                float v8[8], h8[8], m8[8], l8[8];
#pragma unroll
                for (int c = 0; c < 8; ++c) { v8[c] = wf[2 * jb2 + (c >> 2)][c & 3];
                    const unsigned hb = cvt_pk_bf16(v8[c], 0.f) & 0xffffu; h8[c] = __uint_as_float(hb << 16); const float r1 = v8[c] - h8[c];
                    const unsigned mb = cvt_pk_bf16(r1, 0.f) & 0xffffu; m8[c] = __uint_as_float(mb << 16); l8[c] = r1 - m8[c]; }
                const int jb = 2 * jh + jb2;
                wBh[jb] = (u32x4){cvt_pk_bf16(h8[0], h8[1]), cvt_pk_bf16(h8[2], h8[3]), cvt_pk_bf16(h8[4], h8[5]), cvt_pk_bf16(h8[6], h8[7])};
                wBm[jb] = (u32x4){cvt_pk_bf16(m8[0], m8[1]), cvt_pk_bf16(m8[2], m8[3]), cvt_pk_bf16(m8[4], m8[5]), cvt_pk_bf16(m8[6], m8[7])};
                wBl[jb] = (u32x4){cvt_pk_bf16(l8[0], l8[1]), cvt_pk_bf16(l8[2], l8[3]), cvt_pk_bf16(l8[4], l8[5]), cvt_pk_bf16(l8[6], l8[7])};
            }
            asm volatile("" ::: "memory");
        }
        pb = xrow16_sum(pb);
        if (l < 16) biasp[w * 16 + l] = pb;
        u32x4 xa[4], xb[4];
        const int lrow4 = l >> 4, c16 = l & 15;
        const bf16_t* xbase = (const bf16_t*)(P.ws + WS_X1B) + (size_t)(R0 + lrow4) * DM + 128 * w + 8 * c16;
#define H2_LOAD(dst, g_) do { _Pragma("unroll") for (int i = 0; i < 4; ++i) dst[i] = *(const u32x4*)(xbase + (size_t)(16 * (g_) + 4 * i) * DM); } while (0)
#define H2_TILE(xr_) do { _Pragma("unroll") for (int i = 0; i < 4; ++i) { const int row = 4 * i + lrow4; *(LAS u32x4*)(xt + row * 256 + 16 * (c16 ^ row)) = xr_[i]; } } while (0)
        H2_LOAD(xa, 0); H2_LOAD(xb, 1);
        H2_TILE(xa); H2_LOAD(xa, 2);
        __syncthreads();
        float bias_e = 0.f;
#pragma unroll
        for (int w2 = 0; w2 < 8; ++w2) bias_e += biasp[w2 * 16 + r];
          \
#define H2_GROUP(g, xn_) do { \
            f32x4 xv[8]; u32x4 xraw[4]; \
            _Pragma("unroll") for (int jb = 0; jb < 4; ++jb) xraw[jb] = *(const LAS u32x4*)(xt + r * 256 + 16 * ((4 * jb + kq) ^ r)); \
            float s = 0.f, s2 = 0.f; f32x4 acc = (f32x4){0.f, 0.f, 0.f, 0.f}, acc2 = (f32x4){0.f, 0.f, 0.f, 0.f};        \
            _Pragma("unroll") for (int jb = 0; jb < 4; ++jb) { const bf16x8 xf = __builtin_bit_cast(bf16x8, xraw[jb]); \
                acc = __builtin_amdgcn_mfma_f32_16x16x32_bf16(xf, __builtin_bit_cast(bf16x8, wBh[jb]), acc, 0, 0, 0); \
                acc2 = __builtin_amdgcn_mfma_f32_16x16x32_bf16(xf, __builtin_bit_cast(bf16x8, wBm[jb]), acc2, 0, 0, 0); \
                acc2 = __builtin_amdgcn_mfma_f32_16x16x32_bf16(xf, __builtin_bit_cast(bf16x8, wBl[jb]), acc2, 0, 0, 0); \
                unpack8(xraw[jb], xv[2 * jb], xv[2 * jb + 1]); } \
            _Pragma("unroll") for (int j = 0; j < 8; ++j) { s = __builtin_fmaf(xv[j][0], xv[j][0], s); s2 = __builtin_fmaf(xv[j][1], xv[j][1], s2); s = __builtin_fmaf(xv[j][2], xv[j][2], s); s2 = __builtin_fmaf(xv[j][3], xv[j][3], s2); } \
            acc += acc2; s = xrow16_sum(s + s2); \
            const int par = (g) & 1; \
            _Pragma("unroll") for (int i = 0; i < 4; ++i) red[(par * 8 + w) * 256 + (4 * kq + i) * 16 + r] = acc[i];         \
            if (kq == 0) ssq[(par * 16 + r) * 8 + w] = s; \
            __syncthreads(); \
              \
            { const f32x4 s0 = *(const LAS f32x4*)(ssq + (par * 16 + r) * 8), s1 = *(const LAS f32x4*)(ssq + (par * 16 + r) * 8 + 4); \
              const float rinv = __builtin_amdgcn_rsqf(((s0[0] + s0[1]) + (s0[2] + s0[3]) + (s1[0] + s1[1]) + (s1[2] + s1[3])) * (1.0f / DM) + NORM_EPS); \
              _Pragma("unroll") for (int j = 0; j < 8; ++j) { const f32x4 hv = xv[j] * rinv * csl[j] + csl[256 + j]; *(LAS unsigned*)(f8t + r * 144 + 32 * (j >> 1) + 8 * kq + 4 * (j & 1)) = pk4_fp8(hv[0], hv[1], hv[2], hv[3]); } } \
            { const u32x4 o0 = *(const LAS u32x4*)(f8t + (l >> 2) * 144 + 32 * (l & 3)), o1 = *(const LAS u32x4*)(f8t + (l >> 2) * 144 + 32 * (l & 3) + 16); \
              unsigned char* dst = H2 + (size_t)(R0 + 16 * (g) + (l >> 2)) * DM + 128 * w + 32 * (l & 3); \
              *(u32x4*)dst = o0; *(u32x4*)(dst + 16) = o1; } \
              \
            { const int rr = 2 * w + ((l >> 4) & 1); \
              float lg = 0.f; \
              _Pragma("unroll") for (int w2 = 0; w2 < 8; ++w2) lg += red[(par * 8 + w2) * 256 + rr * 16 + r]; \
              const f32x4 s0 = *(const LAS f32x4*)(ssq + (par * 16 + rr) * 8), s1 = *(const LAS f32x4*)(ssq + (par * 16 + rr) * 8 + 4); \
              const float rinv = __builtin_amdgcn_rsqf(((s0[0] + s0[1]) + (s0[2] + s0[3]) + (s1[0] + s1[1]) + (s1[2] + s1[3])) * (1.0f / DM) + NORM_EPS); \
              lg = lg * rinv + bias_e; \
              const float m = row16_max(lg); \
              const float pe = fast_exp2((lg - m) * LOG2E); \
              const float sm = row16_sum(pe); \
              if (l < 32) affl[r * 260 + 16 * (g) + rr] = pe / sm; } \
            H2_TILE(xn_); \
            { const int gl_ = (g) + 3 < 16 ? (g) + 3 : 15; H2_LOAD(xn_, gl_); } \
        } while (0)
#pragma nounroll
        for (int g = 0; g < 16; g += 2) { H2_GROUP(g, xb); H2_GROUP(g + 1, xa); }
#undef H2_GROUP
#undef H2_TILE
#undef H2_LOAD
        __syncthreads();
        { const int e = F.tid >> 5, t8 = (F.tid & 31) * 8;
          const f32x4 v0 = *(const LAS f32x4*)(affl + e * 260 + t8), v1 = *(const LAS f32x4*)(affl + e * 260 + t8 + 4);
          float* d = AFF + (size_t)(b * 16 + e) * SEQ + tb + t8; *(f32x4*)d = v0; *(f32x4*)(d + 4) = v1; }
    }
}

__device__ __forceinline__ unsigned wave_scan_incl(unsigned x) {
    int v = (int)x;
    v += __builtin_amdgcn_update_dpp(0, v, 0x111, 0xf, 0xf, true);
    v += __builtin_amdgcn_update_dpp(0, v, 0x112, 0xf, 0xf, true);
    v += __builtin_amdgcn_update_dpp(0, v, 0x114, 0xf, 0xf, true);
    v += __builtin_amdgcn_update_dpp(0, v, 0x118, 0xf, 0xf, true);
    v += __builtin_amdgcn_update_dpp(0, v, 0x142, 0xa, 0xf, false);
    v += __builtin_amdgcn_update_dpp(0, v, 0x143, 0xc, 0xf, false);
    return (unsigned)v;
}
__device__ __forceinline__ void phase_topk(const Frame& F, const Ptrs& P) {
    const float* AFF = (const float*)(P.ws + WS_AFF); float* GTS = (float*)(P.ws + WS_GTS); short* SLOT = (short*)(P.ws + WS_SLOT);
    LAS unsigned* vals = (LAS unsigned*)F.lds;
    LAS unsigned* hist = (LAS unsigned*)(F.lds + 16384);
    LAS unsigned* sel = (LAS unsigned*)(F.lds + 16384 + 1024);
    LAS unsigned* wsum = (LAS unsigned*)(F.lds + 16384 + 1024 + 64);
    LAS unsigned* wtot = (LAS unsigned*)(F.lds + 16384 + 1024 + 32);
    unsigned short* IDX = (unsigned short*)(P.ws + WS_IDX);
    for (int u = F.vcu; u < 256; u += F.G) {
        const int b = u >> 4, e = u & 15;
        const float* av = AFF + (size_t)(b * 16 + e) * SEQ;
        unsigned v[8];
        { const u32x4 a = *(const u32x4*)(av + 8 * F.tid), c = *(const u32x4*)(av + 8 * F.tid + 4);
          v[0] = a.x; v[1] = a.y; v[2] = a.z; v[3] = a.w; v[4] = c.x; v[5] = c.y; v[6] = c.z; v[7] = c.w; }
        unsigned prefix = 0u, mask = 0u, kk = CAP;
        for (int pass = 0; pass < 4; ++pass) {
            const int shift = 24 - 8 * pass;
            if (F.tid < 256) hist[F.tid] = 0u;
            __syncthreads();
#pragma unroll
            for (int i = 0; i < 8; ++i) if ((v[i] & mask) == prefix) atomicAdd((unsigned*)&hist[(v[i] >> shift) & 255u], 1u);
            __syncthreads();
            unsigned mine = 0u, inc = 0u;
            if (F.tid < 256) {
                mine = hist[F.tid];
                { const unsigned pi_ = wave_scan_incl(mine); inc = (unsigned)__builtin_amdgcn_readlane((int)pi_, 63) - pi_ + mine; }
                if (F.lane == 0) wtot[F.wave] = inc;
            }
            __syncthreads();
            if (F.tid < 256) {
                unsigned sfx = inc - mine;
                for (int w2 = F.wave + 1; w2 < 4; ++w2) sfx += wtot[w2];
                if (sfx < kk && sfx + mine >= kk) { sel[0] = (unsigned)F.tid; sel[1] = kk - sfx; }
            }
            __syncthreads();
            prefix |= sel[0] << shift; mask |= 255u << shift; kk = sel[1];
            __syncthreads();
        }
        const unsigned T = prefix;
        unsigned cg = 0u, ce = 0u;
#pragma unroll
        for (int i = 0; i < 8; ++i) { cg += (v[i] > T) ? 1u : 0u; ce += (v[i] == T) ? 1u : 0u; }
        unsigned pk = cg | (ce << 16), inc = wave_scan_incl(pk);
        if (F.lane == 63) wsum[F.wave] = inc;
        __syncthreads();
        unsigned base = 0u;
        for (int w2 = 0; w2 < F.wave; ++w2) base += wsum[w2];
        unsigned excl = base + inc - pk;
        unsigned ng = excl & 0xffffu, neq = excl >> 16;
        short sl[8];
#pragma unroll
        for (int i = 0; i < 8; ++i) {
            if (v[i] > T) { sl[i] = (short)(ng + (neq < kk ? neq : kk)); ++ng; }
            else if (v[i] == T) { sl[i] = (neq < kk) ? (short)(ng + neq) : (short)-1; ++neq; }
            else sl[i] = (short)-1;
        }
#pragma unroll
        for (int i = 0; i < 8; ++i) {
            const int t = 8 * F.tid + i;
            SLOT[(size_t)e * NT + b * SEQ + t] = sl[i];
            if (sl[i] >= 0) { IDX[(size_t)(e * 16 + b) * 512 + sl[i]] = (unsigned short)t; GTS[(size_t)e * 8192 + b * 512 + sl[i]] = __uint_as_float(v[i]); }
        }
        __syncthreads();
    }
}

struct FinalRow { u32x4 xb0, xb1; u32x2 y[4][2]; unsigned rest; int n; };
__device__ __forceinline__ void final_issue(const Frame& F, const Ptrs& P, const unsigned char* YS, int r, int slv, FinalRow& L) {
    const bf16_t* xp = (const bf16_t*)(P.ws + WS_X1B) + (size_t)r * DM;
    L.xb0 = *(const u32x4*)(xp + 8 * F.lane); L.xb1 = *(const u32x4*)(xp + 512 + 8 * F.lane);
    unsigned m = (unsigned)(__builtin_amdgcn_ballot_w64(slv >= 0) & 0xffffull);
    const int b = r >> 12; int n = 0;
#pragma unroll
    for (int i = 0; i < 4; ++i) {
        const bool on = m != 0u; const int e = on ? __builtin_ctz(m) : 0; if (on) { m &= m - 1u; ++n; }
        int sl = __builtin_amdgcn_readlane(slv, e); sl = on ? sl : 0;
        const u32x2* yp = (const u32x2*)(YS + ((size_t)e * 8192 + b * 512 + sl) * DM);
        L.y[i][0] = yp[F.lane]; L.y[i][1] = yp[64 + F.lane];
    }
    L.rest = m; L.n = n;
}
__device__ __forceinline__ void final_add(const u32x2 y0, const u32x2 y1, float (&a)[16]) {
    { const f32x2 p0 = __builtin_amdgcn_cvt_pk_f32_fp8((int)y0.x, false), p1 = __builtin_amdgcn_cvt_pk_f32_fp8((int)y0.x, true), p2 = __builtin_amdgcn_cvt_pk_f32_fp8((int)y0.y, false), p3 = __builtin_amdgcn_cvt_pk_f32_fp8((int)y0.y, true);
      a[0] += p0[0]; a[1] += p0[1]; a[2] += p1[0]; a[3] += p1[1]; a[4] += p2[0]; a[5] += p2[1]; a[6] += p3[0]; a[7] += p3[1]; }
    { const f32x2 p0 = __builtin_amdgcn_cvt_pk_f32_fp8((int)y1.x, false), p1 = __builtin_amdgcn_cvt_pk_f32_fp8((int)y1.x, true), p2 = __builtin_amdgcn_cvt_pk_f32_fp8((int)y1.y, false), p3 = __builtin_amdgcn_cvt_pk_f32_fp8((int)y1.y, true);
      a[8] += p0[0]; a[9] += p0[1]; a[10] += p1[0]; a[11] += p1[1]; a[12] += p2[0]; a[13] += p2[1]; a[14] += p3[0]; a[15] += p3[1]; }
}
__device__ __forceinline__ void phase_final(const Frame& F, const Ptrs& P, const unsigned char* YS) {
    const float* mod = (const float*)(P.ws + WS_MOD); const short* SLOT = (const short*)(P.ws + WS_SLOT);
    const int gw = F.vcu * NWAVES + F.wave, NGW = F.G * NWAVES;
    const int rpw = (NT + NGW - 1) / NGW, r0 = gw * rpw, r1 = (r0 + rpw < NT) ? r0 + rpw : NT;
    if (r0 >= r1) return;
    const int le = F.lane < 16 ? F.lane : 0;
#define FIN_SLOT(r_) ({ const int rc_ = (r_) < r1 ? (r_) : r1 - 1; const int s_ = SLOT[(size_t)le * NT + rc_]; F.lane < 16 ? s_ : -1; })
    int sl0 = FIN_SLOT(r0);
    FinalRow A, B;
    final_issue(F, P, YS, r0, sl0, A);
    int sl1 = FIN_SLOT(r0 + 1);
    f32x4 gv[4]; int bcur = -1;
    for (int r = r0; r < r1; ++r) {
        const int b = r >> 12;
        const int sl2 = FIN_SLOT(r + 2);
        { const int rn = r + 1 < r1 ? r + 1 : r1 - 1; final_issue(F, P, YS, rn, sl1, B); }
        float* op = P.out + (size_t)r * DM;
        if (b != bcur) { bcur = b;
#pragma unroll
            for (int q = 0; q < 4; ++q) gv[q] = *(const f32x4*)(mod + b * 6144 + 5120 + 512 * (q >> 1) + 8 * F.lane + 4 * (q & 1)) * (1.0f / YS_SCALE); }
        float a[16];
#pragma unroll
        for (int i = 0; i < 16; ++i) a[i] = 0.f;
#pragma unroll
        for (int i = 0; i < 4; ++i) if (i < A.n) final_add(A.y[i][0], A.y[i][1], a);
        for (unsigned m = A.rest; m != 0u; m &= m - 1u) {
            const int e = __builtin_ctz(m); const int sl = __builtin_amdgcn_readlane(sl0, e);
            const u32x2* yp = (const u32x2*)(YS + ((size_t)e * 8192 + b * 512 + sl) * DM);
            final_add(yp[F.lane], yp[64 + F.lane], a);
        }
        f32x4 xv[4]; unpack8(A.xb0, xv[0], xv[1]); unpack8(A.xb1, xv[2], xv[3]);
#pragma unroll
        for (int q = 0; q < 4; ++q) {
            const int c = 512 * (q >> 1) + 8 * F.lane + 4 * (q & 1);
            f32x4 o; o[0] = xv[q][0] + gv[q][0] * a[4 * q]; o[1] = xv[q][1] + gv[q][1] * a[4 * q + 1]; o[2] = xv[q][2] + gv[q][2] * a[4 * q + 2]; o[3] = xv[q][3] + gv[q][3] * a[4 * q + 3];
            *(f32x4*)(op + c) = o;
        }
        A = B; sl0 = sl1; sl1 = sl2;
    }
#undef FIN_SLOT
}

constexpr int N_PHASES = 12;
struct Args { const void* in[24]; float* out; unsigned char* ws; int ph_lo, ph_hi; };
__global__ void __launch_bounds__(NTHR, 2) fwd(Args args) {
    extern __shared__ __attribute__((aligned(16))) unsigned char lds_raw[];
    Frame F; F.lds = (LAS unsigned char*)lds_raw; F.tid = threadIdx.x; F.lane = F.tid & 63; F.wave = __builtin_amdgcn_readfirstlane(F.tid >> 6);
    F.G = gridDim.x; { const int bx = blockIdx.x; F.vcu = (F.G % 8 == 0) ? (bx % 8) * (F.G / 8) + bx / 8 : bx; }
    Ptrs P;
    P.x = (const float*)args.in[0]; P.c = (const float*)args.in[1]; P.positions = (const int*)args.in[2]; P.w_ada = (const float*)args.in[3]; P.b_ada = (const float*)args.in[4];
    P.norm1_w = (const float*)args.in[5]; P.w_in = (const float*)args.in[6]; P.q_norm_w = (const float*)args.in[7]; P.k_norm_w = (const float*)args.in[8]; P.conv_w = (const float*)args.in[9];
    P.conv_b = (const float*)args.in[10]; P.lru_w_a = (const float*)args.in[11]; P.lru_b_a = (const float*)args.in[12]; P.lru_w_x = (const float*)args.in[13]; P.lru_b_x = (const float*)args.in[14];
    P.lru_lambda = (const float*)args.in[15]; P.w_attn_branch = (const float*)args.in[16]; P.w_lru_branch = (const float*)args.in[17]; P.w_out = (const float*)args.in[18];
    P.norm2_w = (const float*)args.in[19]; P.w_router = (const float*)args.in[20]; P.w_gate = (const float*)args.in[21]; P.w_up = (const float*)args.in[22]; P.w_down = (const float*)args.in[23];
    P.out = args.out; P.ws = args.ws;
    volatile LAS unsigned* MISC = (volatile LAS unsigned*)(F.lds + MISC_OFF);
    if (F.tid < 4) MISC[F.tid] = 0u;
    __syncthreads();
    const int lo = args.ph_lo, hi = args.ph_hi;
    XcdBarrier bar; bar.bar = (unsigned*)(P.ws + WS_CTL); bar.x = 0; bar.st = nullptr;
    if (hi - lo > 1) bar = xcd_barrier_post((unsigned*)(P.ws + WS_CTL), MISC);
#ifndef PHASE_MASK
#define PHASE_MASK 0xfff
#endif
#define IN(k) (((PHASE_MASK >> (k)) & 1) && lo <= (k) && (k) < hi)
#define SEAM(k) do { if (IN(k) && IN((k) + 1)) xcd_barrier(bar); } while (0)
    const int G = F.G, cid = (int)blockIdx.x;

#ifndef REPEAT_PHASE
#define REPEAT_PHASE (-1)
#endif
#define RUN(k, ...) do { if (IN(k)) { { __VA_ARGS__ } if (REPEAT_PHASE == (k)) { if (hi - lo > 1) xcd_barrier(bar); { __VA_ARGS__ } } SEAM(k); } } while (0)
    RUN(0, phase_prologue(F, P););
    RUN(1, phase_h1(F, P););
    RUN(2,
        const int xs_ = (F.G % 8 == 0) ? F.vcu / (F.G / 8) : 0;
        convert_expert_items(F, P, 0, xs_ < EXPERT_ITEMS_EARLY ? xs_ : EXPERT_ITEMS_EARLY);
        {   pg8::Gemm g{(const bf16_t*)((unsigned char*)P.out + DO_H18), (const bf16_t*)(P.ws + WS_WIN8), DM / 2, 0, 9, (127 - WIN_SCALE_LOG2) * 0x01010101, nullptr, nullptr, 0}; pg8::StaticOrder S; S.init(NT, 2304, G, cid);
            EpiInProj E{(bf16_t*)(P.ws + WS_QG), (bf16_t*)(P.ws + WS_XR), (const float*)(P.ws + WS_ROPE), P.q_norm_w, P.k_norm_w, 0};
            pg8::gemm_phase<EpiInProj, true, true, true>(F.lds, g, S, E); }
        {   pg8::Gemm g{(const bf16_t*)((unsigned char*)P.out + DO_H1), (const bf16_t*)(P.ws + WS_WIN) + (size_t)2304 * DM, DM, 0, 16, 0, nullptr, nullptr, 0}; pg8::StaticOrder S; S.init(NT, 4096, G, cid);
            EpiInProj E{(bf16_t*)(P.ws + WS_QG), (bf16_t*)(P.ws + WS_XR), (const float*)(P.ws + WS_ROPE), P.q_norm_w, P.k_norm_w, 9};
            pg8::gemm_phase<EpiInProj, true, true>(F.lds, g, S, E); }
        convert_expert_items(F, P, xs_ < EXPERT_ITEMS_EARLY ? xs_ : EXPERT_ITEMS_EARLY, EXPERT_ITEMS_EARLY););
    RUN(3, phase_attn(F, P););
    RUN(4, phase_lru(F, P););
    RUN(5,
        pg8::Gemm g{(const bf16_t*)(P.ws + WS_ATTN), (const bf16_t*)(P.ws + WS_WAB), 256, 0, 4, 0, (const bf16_t*)(P.ws + WS_LRU), (const bf16_t*)(P.ws + WS_WLB), DM}; pg8::StaticOrder S; S.init(NT, DM, G, cid);
        EpiGate<0> E{(bf16_t*)(P.ws + WS_MRG), (const bf16_t*)(P.ws + WS_SGL), nullptr}; MidRatio M{(const bf16_t*)(P.ws + WS_SGA)};
        pg8::gemm_phase<EpiGate<0>, true, true, false, MidRatio>(F.lds, g, S, E, M););
    RUN(6,
        const int xs_ = (F.G % 8 == 0) ? F.vcu / (F.G / 8) : 0; const int pre_ = EXPERT_ITEMS_EARLY + ((EXPERT_ITEMS_ALL - EXPERT_ITEMS_EARLY) * xs_) / 7;
        convert_expert_items(F, P, EXPERT_ITEMS_EARLY, pre_);
        {   pg8::Gemm g{(const bf16_t*)(P.ws + WS_MRG), (const bf16_t*)(P.ws + WS_WOUT), DM, 0, 4, 0, nullptr, nullptr, 0}; pg8::StaticOrder S; S.init(NT, DM, G, cid);
            EpiX1 E{P.x, (bf16_t*)(P.ws + WS_X1B), (const float*)(P.ws + WS_MOD) + 2048};
            pg8::gemm_phase<EpiX1, true, true>(F.lds, g, S, E); }
        convert_expert_items(F, P, pre_, EXPERT_ITEMS_ALL););
    RUN(7, phase_h2(F, P, (unsigned char*)(P.ws + WS_H2)););
    RUN(8, phase_topk(F, P););
    RUN(9,
        pg8::Gemm g{(const bf16_t*)(P.ws + WS_H2), (const bf16_t*)(P.ws + WS_WGU), DM / 2, 32, 16, (127 - WGU_SCALE_LOG2) * 0x01010101, nullptr, nullptr, 0}; pg8::StaticOrder S; S.init(NE * 8192, 4096, G, cid);
        EpiGU E{(unsigned char*)(P.ws + WS_HE)};
        LAS unsigned short* tab = (LAS unsigned short*)(F.lds + GA_TAB_OFF);
        { const unsigned short* IDX = (const unsigned short*)(P.ws + WS_IDX);
          unsigned short tv_[16];
          _Pragma("unroll") for (int q = 0; q < 16; ++q) { pg8::Unit uu; const int ui = 2 * q + (F.tid >> 8); tv_[q] = 0; if (S.next(ui, uu)) tv_[q] = IDX[(size_t)(uu.pm >> 1) * 512 + (uu.pm & 1) * 256 + (F.tid & 255)]; }
          _Pragma("unroll") for (int q = 0; q < 16; ++q) tab[(2 * q + (F.tid >> 8)) * 256 + (F.tid & 255)] = tv_[q]; }
        __syncthreads();
        pg8::gemm_phase<EpiGU, true, true, true, pg8::NoMid, GatherH2>(F.lds, g, S, E, pg8::NoMid{}, GatherH2{tab}););
    RUN(10,
        pg8::Gemm g{(const bf16_t*)(P.ws + WS_HE), (const bf16_t*)(P.ws + WS_WD), FF / 2, 32, 4, (127 - WD_SCALE_LOG2) * 0x01010101, nullptr, nullptr, 0}; pg8::StaticOrder S; S.init(NE * 8192, DM, G, cid);
        EpiDown E{(unsigned char*)(P.ws + WS_YS), (const float*)(P.ws + WS_GTS)};
        pg8::gemm_phase<EpiDown, true, true, true>(F.lds, g, S, E););
    if (IN(11)) { phase_final(F, P, (const unsigned char*)(P.ws + WS_YS)); }
#undef RUN
#undef IN
#undef SEAM
}

extern "C" void kernel_launch(void* const* d_in, const int* in_sizes, int n_in, void* d_out, int out_size, void* d_ws, size_t ws_size, hipStream_t stream) {
    static int grid = 0;
    if (grid == 0) {
        if (n_in != 24 || in_sizes[0] != NT * DM || out_size != NT * DM || ws_size < (size_t)1024 * MiB) {
            fprintf(stderr, "kernel_launch: unexpected shapes (n_in %d, in0 %d, out %d, ws %zu need %zu); nothing launched\n", n_in, n_in > 0 ? in_sizes[0] : -1, out_size, ws_size, (size_t)1024 * MiB); grid = -1; return; }
        int dev = 0, cus = 0, per_cu = 0;
        if (hipGetDevice(&dev) != hipSuccess || hipDeviceGetAttribute(&cus, hipDeviceAttributeMultiprocessorCount, dev) != hipSuccess) { grid = -1; return; }
        if (hipFuncSetAttribute((const void*)fwd, hipFuncAttributeMaxDynamicSharedMemorySize, LDS_BYTES) != hipSuccess) { fprintf(stderr, "kernel_launch: hipFuncSetAttribute failed\n"); grid = -1; return; }
        if (hipOccupancyMaxActiveBlocksPerMultiprocessor(&per_cu, (const void*)fwd, NTHR, LDS_BYTES) != hipSuccess || per_cu < 1) { fprintf(stderr, "kernel_launch: occupancy query says %d blocks per CU\n", per_cu); }
        (void)hipGetLastError();
        grid = cus;
    }
    if (grid < 0) return;
    (void)hipMemsetAsync((char*)d_ws + WS_CTL, 0, CTL_ZERO_BYTES, stream);
    Args a{};
    for (int i = 0; i < 24; ++i) a.in[i] = d_in[i];
    a.out = (float*)d_out; a.ws = (unsigned char*)d_ws;
#if MK_N_LAUNCHES == 1
    a.ph_lo = 0; a.ph_hi = N_PHASES;
    hipLaunchKernelGGL(fwd, dim3(grid), dim3(NTHR), LDS_BYTES, stream, a);
#else
    for (int p = 0; p < N_PHASES; ++p) { a.ph_lo = p; a.ph_hi = p + 1; hipLaunchKernelGGL(fwd, dim3(grid), dim3(NTHR), LDS_BYTES, stream, a); }
#endif
}
```
